# Optimizing an MI355X kernel written in HIP

```python
import math
import jax, jax.numpy as jnp
from jax import lax
import numpy as np

D_MODEL = 1024
BATCH = 16
SEQ = 2048
DEPTH = 1

MIX_WIDTH = D_MODEL
ATT_WIDTH = MIX_WIDTH // 2
SSD_WIDTH = MIX_WIDTH - ATT_WIDTH

DA_HEADS = 4
DA_HEAD_DIM = ATT_WIDTH // (2 * DA_HEADS)
DA_V_DIM = 2 * DA_HEAD_DIM
ROPE_THETA = 10000.0
Q_BLOCK = 128

SSD_HEAD_DIM = 64
SSD_HEADS = SSD_WIDTH // SSD_HEAD_DIM
SSD_GROUPS = 2
SSD_STATE = 128
SSD_CONV = 4
SSD_CHUNK = 128

PEER_HEADS = 8
PEER_NKEYS = 128
PEER_EXPERTS = PEER_NKEYS * PEER_NKEYS
PEER_TOPK = 16
PEER_DKEY = 256
PEER_TOKEN_BLOCK = 128

LN_EPS = 1e-5
RMS_EPS = 1e-5

QK_COLS = DA_HEADS * 2 * DA_HEAD_DIM
V_COLS = DA_HEADS * DA_V_DIM
SSD_BC = SSD_GROUPS * SSD_STATE
CONV_CH = SSD_WIDTH + 2 * SSD_BC
SPLIT_SIZES = [QK_COLS, QK_COLS, V_COLS, SSD_WIDTH, CONV_CH, SSD_HEADS]
IN_COLS = sum(SPLIT_SIZES)

kernel_name = 'hymba_diffattn_ssd_peer_deepnorm'


def layer_norm(x, g, b):
    xf = x.astype(jnp.float32)
    mu = xf.mean(-1, keepdims=True)
    var = jnp.square(xf - mu).mean(-1, keepdims=True)
    return ((xf - mu) * lax.rsqrt(var + LN_EPS) * g + b).astype(x.dtype)


def rms_norm(x, g):
    xf = x.astype(jnp.float32)
    ms = jnp.square(xf).mean(-1, keepdims=True)
    return (xf * lax.rsqrt(ms + RMS_EPS) * g).astype(x.dtype)


def rope_tables(positions):
    inv_freq = ROPE_THETA ** (-jnp.arange(0, DA_HEAD_DIM, 2, dtype=jnp.float32) / DA_HEAD_DIM)
    ang = positions.astype(jnp.float32)[..., None] * inv_freq
    return jnp.cos(ang)[:, :, None, None, :], jnp.sin(ang)[:, :, None, None, :]


def apply_rope(x, cos, sin):
    half = x.shape[-1] // 2
    x1, x2 = x[..., :half], x[..., half:]
    return jnp.concatenate([x1 * cos - x2 * sin, x2 * cos + x1 * sin], axis=-1).astype(x.dtype)


def diff_attention(q, k, v, lam, lambda_init, subln_g):
    b, s = q.shape[0], q.shape[1]
    qh = q.transpose(0, 2, 3, 1, 4)
    kh = k.transpose(0, 2, 3, 1, 4)
    vh = v.transpose(0, 2, 1, 3)
    scale = DA_HEAD_DIM ** -0.5
    outs = []
    for i in range(s // Q_BLOCK):
        lo, hi = i * Q_BLOCK, (i + 1) * Q_BLOCK
        sc = jnp.einsum('bhcqd,bhckd->bhcqk', qh[:, :, :, lo:hi], kh[:, :, :, :hi]).astype(jnp.float32) * scale
        qpos = lo + jnp.arange(Q_BLOCK)
        kpos = jnp.arange(hi)
        sc = jnp.where(kpos[None, :] <= qpos[:, None], sc, -jnp.inf)
        p = jax.nn.softmax(sc, axis=-1)
        w = p[:, :, 0] - lam * p[:, :, 1]
        outs.append(jnp.einsum('bhqk,bhkv->bqhv', w.astype(vh.dtype), vh[:, :, :hi]))
    o = jnp.concatenate(outs, axis=1)
    o = rms_norm(o, subln_g) * (1.0 - lambda_init)
    return o.reshape(b, s, DA_HEADS * DA_V_DIM)


def causal_depthwise_conv(u, w, bias):
    out = lax.conv_general_dilated(u, w[:, None, :], window_strides=(1,), padding=[(SSD_CONV - 1, 0)],
                                   dimension_numbers=('NWC', 'WIO', 'NWC'), feature_group_count=u.shape[-1])
    return out + bias


def segsum_exp(a):
    t = a.shape[-1]
    cs = jnp.cumsum(a, axis=-1)
    diff = cs[..., :, None] - cs[..., None, :]
    mask = jnp.tril(jnp.ones((t, t), dtype=bool))
    return jnp.exp(jnp.where(mask, diff, -jnp.inf))


def ssd_scan(x, dt, A, Bm, Cm):
    b, s, h, p = x.shape
    g, n, l = SSD_GROUPS, SSD_STATE, SSD_CHUNK
    r, c = h // g, s // l
    xd = (x.astype(jnp.float32) * dt[..., None]).reshape(b, c, l, g, r, p)
    a = (dt * A).reshape(b, c, l, g, r).transpose(0, 3, 4, 1, 2)
    Bc = Bm.astype(jnp.float32).reshape(b, c, l, g, n)
    Cc = Cm.astype(jnp.float32).reshape(b, c, l, g, n)
    a_cs = jnp.cumsum(a, axis=-1)
    Lm = segsum_exp(a)
    CB = jnp.einsum('bclgn,bcsgn->bcgls', Cc, Bc)
    y_diag = jnp.einsum('bcgls,bgrcls,bcsgrp->bclgrp', CB, Lm, xd)
    decay = jnp.exp(a_cs[..., -1:] - a_cs)
    states = jnp.einsum('bclgn,bgrcl,bclgrp->cbgrpn', Bc, decay, xd)
    chunk_decay = jnp.exp(a_cs[..., -1]).transpose(3, 0, 1, 2)

    def step(hstate, inp):
        st, dec = inp
        return hstate * dec[..., None, None] + st, hstate

    h0 = jnp.zeros((b, g, r, p, n), jnp.float32)
    _, prev = lax.scan(step, h0, (states, chunk_decay))
    y_off = jnp.einsum('bclgn,cbgrpn,bgrcl->bclgrp', Cc, prev, jnp.exp(a_cs))
    return (y_diag + y_off).reshape(b, s, h, p)


def ssd_mixer(z, xbc, dt_raw, conv_w, conv_b, dt_bias, a_log, d_skip, norm_g):
    b, s = z.shape[0], z.shape[1]
    xbc = jax.nn.silu(causal_depthwise_conv(xbc, conv_w, conv_b))
    xs, Bm, Cm = jnp.split(xbc, [SSD_WIDTH, SSD_WIDTH + SSD_BC], axis=-1)
    dt = jax.nn.softplus(dt_raw.astype(jnp.float32) + dt_bias)
    A = -jnp.exp(a_log.astype(jnp.float32))
    x4 = xs.reshape(b, s, SSD_HEADS, SSD_HEAD_DIM)
    y = ssd_scan(x4, dt, A, Bm.reshape(b, s, SSD_GROUPS, SSD_STATE), Cm.reshape(b, s, SSD_GROUPS, SSD_STATE))
    y = y + d_skip.astype(jnp.float32)[:, None] * x4.astype(jnp.float32)
    y = y.reshape(b, s, SSD_WIDTH) * jax.nn.silu(z.astype(jnp.float32))
    y = rms_norm(y.reshape(b, s, SSD_GROUPS, SSD_WIDTH // SSD_GROUPS), 1.0).reshape(b, s, SSD_WIDTH) * norm_g
    return y.astype(z.dtype)


def peer_ffn(h, w_q, sub_keys, u_tab, v_tab):
    b, s, d = h.shape
    q = jnp.einsum('bsd,dk->bsk', h, w_q).reshape(b, s, PEER_HEADS, 2, PEER_DKEY // 2)
    scores = jnp.einsum('bshcd,hcnd->bshcn', q, sub_keys).astype(jnp.float32)
    s1, i1 = lax.top_k(scores[..., 0, :], PEER_TOPK)
    s2, i2 = lax.top_k(scores[..., 1, :], PEER_TOPK)
    cand = (s1[..., :, None] + s2[..., None, :]).reshape(b, s, PEER_HEADS, PEER_TOPK * PEER_TOPK)
    cand_ids = (i1[..., :, None] * PEER_NKEYS + i2[..., None, :]).reshape(b, s, PEER_HEADS, PEER_TOPK * PEER_TOPK)
    top_s, pos = lax.top_k(cand, PEER_TOPK)
    ids = jnp.take_along_axis(cand_ids, pos, axis=-1)
    gates = jax.nn.softmax(top_s, axis=-1)
    nblk = (b * s) // PEER_TOKEN_BLOCK
    kk = PEER_HEADS * PEER_TOPK
    hb = h.reshape(nblk, PEER_TOKEN_BLOCK, d)
    idb = ids.reshape(nblk, PEER_TOKEN_BLOCK, kk)
    gb = gates.reshape(nblk, PEER_TOKEN_BLOCK, kk).astype(h.dtype)

    def apply(args):
        hx, idx, g = args
        act = jax.nn.gelu(jnp.einsum('td,tkd->tk', hx, u_tab[idx]), approximate=False) * g
        return jnp.einsum('tk,tkd->td', act, v_tab[idx])

    return lax.map(apply, (hb, idb, gb)).reshape(b, s, d)


def setup_inputs(seed: int = 0) -> dict:
    key = jax.random.key(seed)
    ks = jax.random.split(key, 24)
    beta = (8.0 * DEPTH) ** -0.25
    f32 = jnp.float32
    nrm = lambda k, shp: jax.random.normal(k, shp, f32)
    x = nrm(ks[0], (BATCH, SEQ, D_MODEL))
    offs = jax.random.randint(ks[1], (BATCH, 1), 0, 4096, dtype=jnp.int32)
    positions = offs + jnp.arange(SEQ, dtype=jnp.int32)[None, :]
    col_scale = jnp.ones((IN_COLS,), f32)
    col_scale = col_scale.at[2 * QK_COLS:2 * QK_COLS + V_COLS].set(beta)
    xs0 = 2 * QK_COLS + V_COLS + SSD_WIDTH
    col_scale = col_scale.at[xs0:xs0 + SSD_WIDTH].set(beta)
    w_in = nrm(ks[2], (DEPTH, D_MODEL, IN_COLS)) * (D_MODEL ** -0.5) * col_scale
    w_out = nrm(ks[3], (DEPTH, MIX_WIDTH, D_MODEL)) * (MIX_WIDTH ** -0.5) * beta
    lambda_q1 = nrm(ks[4], (DEPTH, DA_HEAD_DIM)) * 0.1
    lambda_k1 = nrm(ks[5], (DEPTH, DA_HEAD_DIM)) * 0.1
    lambda_q2 = nrm(ks[6], (DEPTH, DA_HEAD_DIM)) * 0.1
    lambda_k2 = nrm(ks[7], (DEPTH, DA_HEAD_DIM)) * 0.1
    subln_g = 1.0 + 0.02 * nrm(ks[8], (DEPTH, DA_V_DIM))
    conv_w = jax.random.uniform(ks[9], (DEPTH, SSD_CONV, CONV_CH), f32, -0.5, 0.5)
    conv_b = 0.02 * nrm(ks[10], (DEPTH, CONV_CH))
    dt0 = jnp.exp(jax.random.uniform(ks[11], (DEPTH, SSD_HEADS), f32, math.log(1e-3), math.log(1e-1)))
    dt_bias = dt0 + jnp.log(-jnp.expm1(-dt0))
    a_log = jnp.log(jax.random.uniform(ks[12], (DEPTH, SSD_HEADS), f32, 1.0, 16.0))
    d_skip = 1.0 + 0.1 * nrm(ks[13], (DEPTH, SSD_HEADS))
    ssd_norm_g = 1.0 + 0.02 * nrm(ks[14], (DEPTH, SSD_WIDTH))
    ln1_g = 1.0 + 0.02 * nrm(ks[15], (DEPTH, D_MODEL))
    ln1_b = 0.02 * nrm(ks[16], (DEPTH, D_MODEL))
    peer_wq = nrm(ks[17], (DEPTH, D_MODEL, PEER_HEADS * PEER_DKEY)) * (D_MODEL ** -0.5)
    peer_keys = nrm(ks[18], (DEPTH, PEER_HEADS, 2, PEER_NKEYS, PEER_DKEY // 2)) * ((PEER_DKEY // 2) ** -0.5)
    peer_u = nrm(ks[19], (DEPTH, PEER_EXPERTS, D_MODEL)) * (D_MODEL ** -0.5) * beta
    peer_v = nrm(ks[20], (DEPTH, PEER_EXPERTS, D_MODEL)) * beta
    ln2_g = 1.0 + 0.02 * nrm(ks[21], (DEPTH, D_MODEL))
    ln2_b = 0.02 * nrm(ks[22], (DEPTH, D_MODEL))
    return {'x': x, 'positions': positions, 'w_in': w_in, 'w_out': w_out,
            'lambda_q1': lambda_q1, 'lambda_k1': lambda_k1, 'lambda_q2': lambda_q2, 'lambda_k2': lambda_k2,
            'subln_g': subln_g, 'conv_w': conv_w, 'conv_b': conv_b, 'dt_bias': dt_bias, 'a_log': a_log,
            'd_skip': d_skip, 'ssd_norm_g': ssd_norm_g, 'ln1_g': ln1_g, 'ln1_b': ln1_b,
            'peer_wq': peer_wq, 'peer_keys': peer_keys, 'peer_u': peer_u, 'peer_v': peer_v,
            'ln2_g': ln2_g, 'ln2_b': ln2_b}


def reference(x, positions, w_in, w_out, lambda_q1, lambda_k1, lambda_q2, lambda_k2, subln_g,
              conv_w, conv_b, dt_bias, a_log, d_skip, ssd_norm_g, ln1_g, ln1_b,
              peer_wq, peer_keys, peer_u, peer_v, ln2_g, ln2_b):
    b, s, _ = x.shape
    alpha = (2.0 * DEPTH) ** 0.25
    cos, sin = rope_tables(positions)
    split_at = np.cumsum(SPLIT_SIZES)[:-1].tolist()
    for l in range(DEPTH):
        lambda_init = 0.8 - 0.6 * math.exp(-0.3 * l)
        proj = jnp.einsum('bsd,dk->bsk', x, w_in[l])
        q, k, v, z, xbc, dt_raw = jnp.split(proj, split_at, axis=-1)
        q = apply_rope(q.reshape(b, s, DA_HEADS, 2, DA_HEAD_DIM), cos, sin)
        k = apply_rope(k.reshape(b, s, DA_HEADS, 2, DA_HEAD_DIM), cos, sin)
        v = v.reshape(b, s, DA_HEADS, DA_V_DIM)
        lam = (jnp.exp(jnp.sum(lambda_q1[l].astype(jnp.float32) * lambda_k1[l]))
               - jnp.exp(jnp.sum(lambda_q2[l].astype(jnp.float32) * lambda_k2[l])) + lambda_init)
        att = diff_attention(q, k, v, lam, lambda_init, subln_g[l])
        ssd = ssd_mixer(z, xbc, dt_raw, conv_w[l], conv_b[l], dt_bias[l], a_log[l], d_skip[l], ssd_norm_g[l])
        mix = jnp.einsum('bsk,kd->bsd', jnp.concatenate([att, ssd], axis=-1), w_out[l])
        x = layer_norm(alpha * x + mix, ln1_g[l], ln1_b[l])
        ffn = peer_ffn(x, peer_wq[l], peer_keys[l], peer_u[l], peer_v[l])
        x = layer_norm(alpha * x + ffn, ln2_g[l], ln2_b[l])
    return x
```

```cpp
#include <hip/hip_runtime.h>
#include <stdint.h>

typedef unsigned short bf16;
typedef unsigned int u32;

constexpr int NB = 16, SEQ = 2048, DM = 1024, NT = NB * SEQ;
constexpr int NIN = 3080;
constexpr float ALPHA = 1.189207115002721f;
constexpr float LAMBDA_INIT = 0.2f;

__device__ __forceinline__ bf16 f2bf(float f) { u32 u = __float_as_uint(f); u += 0x7FFFu + ((u >> 16) & 1u); return (bf16)(u >> 16); }
__device__ __forceinline__ float bf2f(bf16 h) { return __uint_as_float(((u32)h) << 16); }
__device__ __forceinline__ float silu_f(float v) { return v / (1.0f + __expf(-v)); }
__device__ __forceinline__ float wave_sum(float v) {
#pragma unroll
    for (int o = 32; o > 0; o >>= 1) v += __shfl_xor(v, o);
    return v;
}
__device__ __forceinline__ float wave_max(float v) {
#pragma unroll
    for (int o = 32; o > 0; o >>= 1) v = fmaxf(v, __shfl_xor(v, o));
    return v;
}

constexpr size_t MiB = 1024 * 1024;
constexpr size_t OFF_CTRL = 0;
constexpr size_t OFF_WINT = 1 * MiB;
constexpr size_t OFF_WOUTT = 7 * MiB;
constexpr size_t OFF_WQT = 9 * MiB;
constexpr size_t OFF_KEYS = 13 * MiB;
constexpr size_t OFF_LAM = 13 * MiB + 512 * 1024;
constexpr size_t OFF_DT = 14 * MiB;
constexpr size_t OFF_SSQ = 15 * MiB;
constexpr size_t OFF_ROPEC = 16 * MiB;
constexpr size_t OFF_ROPES = 20 * MiB;
constexpr size_t OFF_UT = 24 * MiB;
constexpr size_t OFF_VT = 56 * MiB;
constexpr size_t OFF_R1 = 88 * MiB;
constexpr size_t OFF_R2 = 152 * MiB;
constexpr size_t OFF_QR = OFF_R2;
constexpr size_t OFF_KR = OFF_R2 + 32 * MiB;
constexpr size_t OFF_VTT = OFF_R2 + 64 * MiB;
constexpr size_t OFF_Z = OFF_R2 + 96 * MiB;
constexpr size_t OFF_XBC = OFF_R2 + 128 * MiB;
constexpr size_t OFF_Y1 = OFF_R2;
constexpr size_t OFF_PQ = OFF_R2;
constexpr size_t OFF_R3 = 344 * MiB;
constexpr size_t OFF_XS = OFF_R3;
constexpr size_t OFF_XT = OFF_R3 + 32 * MiB;
constexpr size_t OFF_BT = OFF_R3 + 64 * MiB;
constexpr size_t OFF_CN = OFF_R3 + 80 * MiB;
constexpr size_t OFF_CB = OFF_R3 + 96 * MiB;
constexpr size_t OFF_BN = 456 * MiB;
constexpr size_t OFF_YT = OFF_XBC;

struct P {
    const float* x; const int* pos; const float* w_in; const float* w_out;
    const float* lq1; const float* lk1; const float* lq2; const float* lk2; const float* subln_g;
    const float* conv_w; const float* conv_b; const float* dt_bias; const float* a_log; const float* d_skip;
    const float* ssd_norm_g; const float* ln1_g; const float* ln1_b; const float* peer_wq; const float* peer_keys;
    const float* peer_u; const float* peer_v; const float* ln2_g; const float* ln2_b;
    float* out; unsigned char* ws;
};
#define WS(T, off) ((T*)(p.ws + (off)))

__global__ void __launch_bounds__(256) k_prep_x(P p) {
    const int wid = threadIdx.x >> 6, lane = threadIdx.x & 63;
    const int tok = blockIdx.x * 4 + wid;
    const float* xr = p.x + (size_t)tok * DM;
    bf16* xb = WS(bf16, OFF_R1) + (size_t)tok * DM;
    float acc[8];
#pragma unroll
    for (int j = 0; j < 8; ++j) acc[j] = 0.f;
    for (int k = lane; k < DM; k += 64) {
        const float v = xr[k];
        xb[k] = f2bf(v);
        const float* wr = p.w_in + (size_t)k * NIN + 3072;
#pragma unroll
        for (int j = 0; j < 8; ++j) acc[j] += v * wr[j];
    }
#pragma unroll
    for (int j = 0; j < 8; ++j) acc[j] = wave_sum(acc[j]);
    if (lane < 8) {
        float v = 0.f;
#pragma unroll
        for (int j = 0; j < 8; ++j) if (lane == j) v = acc[j];
        v += p.dt_bias[lane];
        const float sp = fmaxf(v, 0.f) + log1pf(expf(-fabsf(v)));
        WS(float, OFF_DT)[(size_t)tok * 8 + lane] = sp;
    }
    if (lane < 32) {
        const float inv_freq = powf(10000.0f, -(float)(2 * lane) / 64.0f);
        const float ang = (float)p.pos[tok] * inv_freq;
        WS(float, OFF_ROPEC)[(size_t)tok * 32 + lane] = cosf(ang);
        WS(float, OFF_ROPES)[(size_t)tok * 32 + lane] = sinf(ang);
    }
    if (tok == 0 && lane == 0) {
        float s1 = 0.f, s2 = 0.f;
        for (int i = 0; i < 64; ++i) { s1 += p.lq1[i] * p.lk1[i]; s2 += p.lq2[i] * p.lk2[i]; }
        WS(float, OFF_LAM)[0] = expf(s1) - expf(s2) + LAMBDA_INIT;
    }
    if (lane < 2) WS(float, OFF_SSQ)[(size_t)tok * 2 + lane] = 0.f;
}
__global__ void __launch_bounds__(256) k_prep_w(P p) {
    const size_t gid = (size_t)blockIdx.x * 256 + threadIdx.x, gsz = (size_t)gridDim.x * 256;
    for (size_t i = gid; i < (size_t)3072 * 1024; i += gsz) { const int n = (int)(i / 1024), k = (int)(i % 1024); WS(bf16, OFF_WINT)[i] = f2bf(p.w_in[(size_t)k * NIN + n]); }
    for (size_t i = gid; i < (size_t)1024 * 1024; i += gsz) { const int n = (int)(i / 1024), k = (int)(i % 1024);
        float w = p.w_out[(size_t)k * 1024 + n]; if (k >= 512) w *= p.ssd_norm_g[k - 512]; WS(bf16, OFF_WOUTT)[i] = f2bf(w); }
    for (size_t i = gid; i < (size_t)2048 * 1024; i += gsz) { const int n = (int)(i / 1024), k = (int)(i % 1024); WS(bf16, OFF_WQT)[i] = f2bf(p.peer_wq[(size_t)k * 2048 + n]); }
    for (size_t i = gid; i < (size_t)8 * 2 * 128 * 128; i += gsz) WS(bf16, OFF_KEYS)[i] = f2bf(p.peer_keys[i]);
    for (size_t i = gid; i < (size_t)16384 * 1024; i += gsz) { WS(bf16, OFF_UT)[i] = f2bf(p.peer_u[i]); WS(bf16, OFF_VT)[i] = f2bf(p.peer_v[i]); }
}

__device__ __forceinline__ float dot_bf(const bf16* a, const bf16* b, int n) {
    float s = 0.f;
    for (int k = 0; k < n; k += 8) {
        const uint4 va = *(const uint4*)(a + k), vb = *(const uint4*)(b + k);
        const u32 aw[4] = {va.x, va.y, va.z, va.w}, bw[4] = {vb.x, vb.y, vb.z, vb.w};
#pragma unroll
        for (int j = 0; j < 4; ++j) {
            s += __uint_as_float(aw[j] << 16) * __uint_as_float(bw[j] << 16);
            s += __uint_as_float(aw[j] & 0xFFFF0000u) * __uint_as_float(bw[j] & 0xFFFF0000u);
        }
    }
    return s;
}
__global__ void __launch_bounds__(256) k_inproj_naive(P p) {
    const size_t gid = (size_t)blockIdx.x * 256 + threadIdx.x;
    const int tok = (int)(gid / 2560), j = (int)(gid % 2560);
    if (tok >= NT) return;
    const bf16* xr = WS(bf16, OFF_R1) + (size_t)tok * DM;
    const bf16* W = WS(bf16, OFF_WINT);
    const int b = tok / SEQ, s = tok % SEQ;
    if (j < 512) {
        const int part = j / 256, hc = (j % 256) / 32, i = j % 32;
        const int c1 = part * 512 + hc * 64 + i, c2 = c1 + 32;
        const float x1 = dot_bf(xr, W + (size_t)c1 * DM, DM), x2 = dot_bf(xr, W + (size_t)c2 * DM, DM);
        const float cs = WS(float, OFF_ROPEC)[(size_t)tok * 32 + i], sn = WS(float, OFF_ROPES)[(size_t)tok * 32 + i];
        float o1 = x1 * cs - x2 * sn, o2 = x2 * cs + x1 * sn;
        if (part == 0) { o1 *= 0.125f; o2 *= 0.125f; }
        bf16* dst = WS(bf16, part == 0 ? OFF_QR : OFF_KR) + (size_t)tok * 512 + hc * 64 + i;
        dst[0] = f2bf(o1); dst[32] = f2bf(o2);
    } else {
        const int col = 1024 + (j - 512);
        const float v = dot_bf(xr, W + (size_t)col * DM, DM);
        if (col < 1536) { const int c = col - 1024, h = c / 128, dv = c % 128; WS(bf16, OFF_VTT)[(((size_t)b * 4 + h) * 128 + dv) * SEQ + s] = f2bf(v); }
        else if (col < 2048) WS(bf16, OFF_Z)[(size_t)tok * 512 + (col - 1536)] = f2bf(v);
        else WS(bf16, OFF_XBC)[(size_t)tok * 1024 + (col - 2048)] = f2bf(v);
    }
}

__global__ void __launch_bounds__(256) k_conv_naive(P p) {
    const size_t gid = (size_t)blockIdx.x * 256 + threadIdx.x;
    const int tok = (int)(gid / 1024), ch = (int)(gid % 1024);
    if (tok >= NT) return;
    const int b = tok / SEQ, s = tok % SEQ;
    float acc = p.conv_b[ch];
#pragma unroll
    for (int j = 0; j < 4; ++j) { const int ss = s - 3 + j; if (ss >= 0) acc += p.conv_w[j * 1024 + ch] * bf2f(WS(bf16, OFF_XBC)[(size_t)(tok - 3 + j) * 1024 + ch]); }
    const bf16 o = f2bf(silu_f(acc));
    if (ch < 512) { WS(bf16, OFF_XS)[(size_t)tok * 512 + ch] = o; const int h = ch / 64, pp = ch % 64; WS(bf16, OFF_XT)[(((size_t)b * 8 + h) * 64 + pp) * SEQ + s] = o; }
    else if (ch < 768) { const int c = ch - 512, g = c / 128, n = c % 128; WS(bf16, OFF_BT)[(((size_t)b * 2 + g) * 128 + n) * SEQ + s] = o; WS(bf16, OFF_BN)[(size_t)tok * 256 + c] = o; }
    else WS(bf16, OFF_CN)[(size_t)tok * 256 + (ch - 768)] = o;
}
__global__ void __launch_bounds__(256) k_cb_naive(P p) {
    const size_t gid = (size_t)blockIdx.x * 256 + threadIdx.x;
    const int j = (int)(gid % 128), i = (int)((gid / 128) % 128), g = (int)((gid / 16384) % 2), c = (int)((gid / 32768) % 16), b = (int)(gid / 524288);
    if (b >= NB) return;
    const size_t ti = (size_t)b * SEQ + c * 128 + i, tj = (size_t)b * SEQ + c * 128 + j;
    const float v = dot_bf(WS(bf16, OFF_CN) + ti * 256 + g * 128, WS(bf16, OFF_BN) + tj * 256 + g * 128, 128);
    WS(bf16, OFF_CB)[gid] = f2bf(v);
}

__global__ void __launch_bounds__(128) k_attn_naive(P p) {
    __shared__ float sc0[SEQ], sc1[SEQ], red[8];
    const int tid = threadIdx.x, lane = tid & 63, wid = tid >> 6;
    const int s = blockIdx.x % SEQ, h = (blockIdx.x / SEQ) % 4, b = blockIdx.x / (SEQ * 4);
    const size_t tq = (size_t)b * SEQ + s;
    const bf16* q0 = WS(bf16, OFF_QR) + tq * 512 + h * 128;
    float m0 = -1e30f, m1 = -1e30f;
    for (int k = tid; k <= s; k += 128) {
        const bf16* kr = WS(bf16, OFF_KR) + ((size_t)b * SEQ + k) * 512 + h * 128;
        const float a0 = dot_bf(q0, kr, 64), a1 = dot_bf(q0 + 64, kr + 64, 64);
        sc0[k] = a0; sc1[k] = a1; m0 = fmaxf(m0, a0); m1 = fmaxf(m1, a1);
    }
    m0 = wave_max(m0); m1 = wave_max(m1);
    if (lane == 0) { red[wid] = m0; red[2 + wid] = m1; }
    __syncthreads();
    m0 = fmaxf(red[0], red[1]); m1 = fmaxf(red[2], red[3]);
    float l0 = 0.f, l1 = 0.f;
    for (int k = tid; k <= s; k += 128) { const float e0 = __expf(sc0[k] - m0), e1 = __expf(sc1[k] - m1); sc0[k] = e0; sc1[k] = e1; l0 += e0; l1 += e1; }
    l0 = wave_sum(l0); l1 = wave_sum(l1);
    if (lane == 0) { red[4 + wid] = l0; red[6 + wid] = l1; }
    __syncthreads();
    l0 = red[4] + red[5]; l1 = red[6] + red[7];
    const float lam = WS(float, OFF_LAM)[0];
    const float i0 = 1.0f / l0, i1 = lam / l1;
    for (int k = tid; k <= s; k += 128) sc0[k] = sc0[k] * i0 - sc1[k] * i1;
    __syncthreads();
    const bf16* vr = WS(bf16, OFF_VTT) + (((size_t)b * 4 + h) * 128 + tid) * SEQ;
    float o = 0.f;
    for (int k = 0; k <= s; ++k) o += sc0[k] * bf2f(vr[k]);
    float ss = wave_sum(o * o);
    __syncthreads();
    if (lane == 0) red[wid] = ss;
    __syncthreads();
    ss = red[0] + red[1];
    const float r = rsqrtf(ss / 128.0f + 1e-5f);
    WS(bf16, OFF_R1)[tq * 1024 + h * 128 + tid] = f2bf(o * r * p.subln_g[tid] * (1.0f - LAMBDA_INIT));
}

__global__ void __launch_bounds__(256) k_ssd_naive(P p) {
    const int b = blockIdx.x / 8, h = blockIdx.x % 8, g = h / 4;
    const int tid = threadIdx.x, pp = tid >> 2, nq = tid & 3;
    const float A = -expf(p.a_log[h]), Dh = p.d_skip[h];
    float st[32];
#pragma unroll
    for (int i = 0; i < 32; ++i) st[i] = 0.f;
    for (int s = 0; s < SEQ; ++s) {
        const size_t tok = (size_t)b * SEQ + s;
        const float dt = WS(float, OFF_DT)[tok * 8 + h];
        const float dA = expf(dt * A);
        const float xv = bf2f(WS(bf16, OFF_XS)[tok * 512 + h * 64 + pp]);
        const bf16* Br = WS(bf16, OFF_BN) + tok * 256 + g * 128 + nq * 32;
        const bf16* Cr = WS(bf16, OFF_CN) + tok * 256 + g * 128 + nq * 32;
        const float xd = xv * dt;
        float y = 0.f;
#pragma unroll
        for (int i = 0; i < 32; ++i) { st[i] = st[i] * dA + xd * bf2f(Br[i]); y += st[i] * bf2f(Cr[i]); }
        y += __shfl_xor(y, 1); y += __shfl_xor(y, 2);
        if (nq == 0) WS(float, OFF_YT)[tok * 512 + h * 64 + pp] = y + Dh * xv;
    }
}
__global__ void __launch_bounds__(256) k_ssdgate_naive(P p) {
    __shared__ float red[4];
    const int tok = blockIdx.x / 2, g = blockIdx.x % 2, tid = threadIdx.x, ch = g * 256 + tid;
    const float y = WS(float, OFF_YT)[(size_t)tok * 512 + ch] * silu_f(bf2f(WS(bf16, OFF_Z)[(size_t)tok * 512 + ch]));
    float ss = wave_sum(y * y);
    if ((tid & 63) == 0) red[tid >> 6] = ss;
    __syncthreads();
    if (tid == 0) WS(float, OFF_SSQ)[(size_t)tok * 2 + g] = red[0] + red[1] + red[2] + red[3];
    WS(bf16, OFF_R1)[(size_t)tok * 1024 + 512 + ch] = f2bf(y);
}

__global__ void __launch_bounds__(256) k_outproj_naive(P p) {
    const size_t gid = (size_t)blockIdx.x * 256 + threadIdx.x;
    const int tok = (int)(gid / 1024), n = (int)(gid % 1024);
    if (tok >= NT) return;
    const bf16* a = WS(bf16, OFF_R1) + (size_t)tok * 1024;
    const bf16* w = WS(bf16, OFF_WOUTT) + (size_t)n * 1024;
    const float r0 = rsqrtf(WS(float, OFF_SSQ)[(size_t)tok * 2] / 256.0f + 1e-5f), r1 = rsqrtf(WS(float, OFF_SSQ)[(size_t)tok * 2 + 1] / 256.0f + 1e-5f);
    const float v = dot_bf(a, w, 512) + r0 * dot_bf(a + 512, w + 512, 256) + r1 * dot_bf(a + 768, w + 768, 256);
    WS(float, OFF_Y1)[gid] = ALPHA * p.x[gid] + v;
}
__global__ void __launch_bounds__(256) k_ln1(P p) {
    const int wid = threadIdx.x >> 6, lane = threadIdx.x & 63;
    const int tok = blockIdx.x * 4 + wid;
    const float* yr = WS(float, OFF_Y1) + (size_t)tok * DM;
    float v[16]; float s = 0.f;
#pragma unroll
    for (int i = 0; i < 4; ++i) { const float4 t = *(const float4*)(yr + i * 256 + lane * 4); v[4 * i] = t.x; v[4 * i + 1] = t.y; v[4 * i + 2] = t.z; v[4 * i + 3] = t.w; s += t.x + t.y + t.z + t.w; }
    const float mu = wave_sum(s) * (1.0f / 1024.0f);
    float q = 0.f;
#pragma unroll
    for (int i = 0; i < 16; ++i) { const float d = v[i] - mu; q += d * d; }
    const float rs = rsqrtf(wave_sum(q) * (1.0f / 1024.0f) + 1e-5f);
    bf16* hr = WS(bf16, OFF_R1) + (size_t)tok * DM;
#pragma unroll
    for (int i = 0; i < 4; ++i) {
        const int c = i * 256 + lane * 4;
        ushort4 o;
        o.x = f2bf((v[4 * i] - mu) * rs * p.ln1_g[c] + p.ln1_b[c]); o.y = f2bf((v[4 * i + 1] - mu) * rs * p.ln1_g[c + 1] + p.ln1_b[c + 1]);
        o.z = f2bf((v[4 * i + 2] - mu) * rs * p.ln1_g[c + 2] + p.ln1_b[c + 2]); o.w = f2bf((v[4 * i + 3] - mu) * rs * p.ln1_g[c + 3] + p.ln1_b[c + 3]);
        *(ushort4*)(hr + c) = o;
    }
}
__global__ void __launch_bounds__(256) k_peerq_naive(P p) {
    const size_t gid = (size_t)blockIdx.x * 256 + threadIdx.x;
    const int tok = (int)(gid / 2048), n = (int)(gid % 2048);
    if (tok >= NT) return;
    WS(bf16, OFF_PQ)[gid] = f2bf(dot_bf(WS(bf16, OFF_R1) + (size_t)tok * 1024, WS(bf16, OFF_WQT) + (size_t)n * 1024, 1024));
}
__global__ void __launch_bounds__(256) k_peer_naive(P p) {
    __shared__ float sc[16][128];
    __shared__ float ts[16][16];
    __shared__ int ti[16][16];
    __shared__ float cand[8][256];
    __shared__ int ids[128];
    __shared__ float gate[128];
    __shared__ float act[128];
    __shared__ float red[8];
    const int tok = blockIdx.x, tid = threadIdx.x, lane = tid & 63, wid = tid >> 6;
    const bf16* q = WS(bf16, OFF_PQ) + (size_t)tok * 2048;
    const bf16* hrow = WS(bf16, OFF_R1) + (size_t)tok * 1024;
    for (int idx = tid; idx < 2048; idx += 256) { const int hc = idx / 128, n = idx % 128; sc[hc][n] = dot_bf(q + hc * 128, WS(bf16, OFF_KEYS) + ((size_t)hc * 128 + n) * 128, 128); }
    __syncthreads();
    if (tid < 16) {
        for (int r = 0; r < 16; ++r) {
            float best = -3.0e38f; int bi = 0;
            for (int n = 0; n < 128; ++n) { const float v = sc[tid][n]; if (v > best) { best = v; bi = n; } }
            ts[tid][r] = best; ti[tid][r] = bi; sc[tid][bi] = -3.4e38f;
        }
    }
    __syncthreads();
    for (int idx = tid; idx < 2048; idx += 256) { const int h = idx / 256, i = (idx % 256) / 16, j = idx % 16; cand[h][idx % 256] = ts[2 * h][i] + ts[2 * h + 1][j]; }
    __syncthreads();
    if (tid < 8) {
        float tv[16]; float mx = -3.0e38f;
#pragma unroll
        for (int r = 0; r < 16; ++r) {
            float best = -3.0e38f; int bi = 0;
            for (int n = 0; n < 256; ++n) { const float v = cand[tid][n]; if (v > best) { best = v; bi = n; } }
            cand[tid][bi] = -3.4e38f; tv[r] = best; mx = fmaxf(mx, best);
            ids[tid * 16 + r] = ti[2 * tid][bi / 16] * 128 + ti[2 * tid + 1][bi % 16];
        }
        float sum = 0.f;
#pragma unroll
        for (int r = 0; r < 16; ++r) { tv[r] = expf(tv[r] - mx); sum += tv[r]; }
#pragma unroll
        for (int r = 0; r < 16; ++r) gate[tid * 16 + r] = tv[r] / sum;
    }
    __syncthreads();
    for (int k = wid * 32; k < wid * 32 + 32; ++k) {
        const bf16* ur = WS(bf16, OFF_UT) + (size_t)ids[k] * 1024;
        float s = dot_bf(hrow + lane * 16, ur + lane * 16, 16);
        s = wave_sum(s);
        if (lane == 0) act[k] = 0.5f * s * (1.0f + erff(s * 0.70710678118654752f)) * gate[k];
    }
    __syncthreads();
    float acc[4] = {0.f, 0.f, 0.f, 0.f};
    for (int k = 0; k < 128; ++k) {
        const ushort4 v = *(const ushort4*)(WS(bf16, OFF_VT) + (size_t)ids[k] * 1024 + tid * 4);
        const float a = act[k];
        acc[0] += a * bf2f(v.x); acc[1] += a * bf2f(v.y); acc[2] += a * bf2f(v.z); acc[3] += a * bf2f(v.w);
    }
    const ushort4 hv = *(const ushort4*)(hrow + tid * 4);
    float y[4] = {ALPHA * bf2f(hv.x) + acc[0], ALPHA * bf2f(hv.y) + acc[1], ALPHA * bf2f(hv.z) + acc[2], ALPHA * bf2f(hv.w) + acc[3]};
    float s = wave_sum(y[0] + y[1] + y[2] + y[3]);
    if (lane == 0) red[wid] = s;
    __syncthreads();
    const float mu = (red[0] + red[1] + red[2] + red[3]) * (1.0f / 1024.0f);
    float qq = 0.f;
#pragma unroll
    for (int i = 0; i < 4; ++i) { const float d = y[i] - mu; qq += d * d; }
    qq = wave_sum(qq);
    if (lane == 0) red[4 + wid] = qq;
    __syncthreads();
    const float rs = rsqrtf((red[4] + red[5] + red[6] + red[7]) * (1.0f / 1024.0f) + 1e-5f);
    float4 o;
    const int c = tid * 4;
    o.x = (y[0] - mu) * rs * p.ln2_g[c] + p.ln2_b[c]; o.y = (y[1] - mu) * rs * p.ln2_g[c + 1] + p.ln2_b[c + 1];
    o.z = (y[2] - mu) * rs * p.ln2_g[c + 2] + p.ln2_b[c + 2]; o.w = (y[3] - mu) * rs * p.ln2_g[c + 3] + p.ln2_b[c + 3];
    *(float4*)(p.out + (size_t)tok * 1024 + c) = o;
}

extern "C" void kernel_launch(void* const* d_in, const int* in_sizes, int n_in, void* d_out, int out_size, void* d_ws, size_t ws_size, hipStream_t stream) {
    P p{};
    p.x = (const float*)d_in[0]; p.pos = (const int*)d_in[1]; p.w_in = (const float*)d_in[2]; p.w_out = (const float*)d_in[3];
    p.lq1 = (const float*)d_in[4]; p.lk1 = (const float*)d_in[5]; p.lq2 = (const float*)d_in[6]; p.lk2 = (const float*)d_in[7]; p.subln_g = (const float*)d_in[8];
    p.conv_w = (const float*)d_in[9]; p.conv_b = (const float*)d_in[10]; p.dt_bias = (const float*)d_in[11]; p.a_log = (const float*)d_in[12]; p.d_skip = (const float*)d_in[13];
    p.ssd_norm_g = (const float*)d_in[14]; p.ln1_g = (const float*)d_in[15]; p.ln1_b = (const float*)d_in[16]; p.peer_wq = (const float*)d_in[17]; p.peer_keys = (const float*)d_in[18];
    p.peer_u = (const float*)d_in[19]; p.peer_v = (const float*)d_in[20]; p.ln2_g = (const float*)d_in[21]; p.ln2_b = (const float*)d_in[22];
    p.out = (float*)d_out; p.ws = (unsigned char*)d_ws;
    k_prep_x<<<NT / 4, 256, 0, stream>>>(p);
    k_prep_w<<<2048, 256, 0, stream>>>(p);
    k_inproj_naive<<<(unsigned)((size_t)NT * 2560 / 256), 256, 0, stream>>>(p);
    k_conv_naive<<<NT * 1024 / 256, 256, 0, stream>>>(p);
    k_cb_naive<<<16 * 16 * 2 * 128 * 128 / 256, 256, 0, stream>>>(p);
    k_attn_naive<<<NB * 4 * SEQ, 128, 0, stream>>>(p);
    k_ssd_naive<<<NB * 8, 256, 0, stream>>>(p);
    k_ssdgate_naive<<<NT * 2, 256, 0, stream>>>(p);
    k_outproj_naive<<<NT * 1024 / 256, 256, 0, stream>>>(p);
    k_ln1<<<NT / 4, 256, 0, stream>>>(p);
    k_peerq_naive<<<NT * 2048 / 256, 256, 0, stream>>>(p);
    k_peer_naive<<<NT, 256, 0, stream>>>(p);
}
```

```cpp
#include <hip/hip_runtime.h>
#include <stdint.h>

typedef unsigned short bf16;
typedef unsigned int u32;
typedef short bf16x8 __attribute__((ext_vector_type(8)));
typedef float f32x4 __attribute__((ext_vector_type(4)));
typedef float f32x2 __attribute__((ext_vector_type(2)));
typedef unsigned u32x2 __attribute__((ext_vector_type(2)));
typedef unsigned u32x4 __attribute__((ext_vector_type(4)));

constexpr int NB = 16, SEQ = 2048, DM = 1024, NT = NB * SEQ;
constexpr int NIN = 3080;
constexpr float ALPHA = 1.189207115002721f;
constexpr float LAMBDA_INIT = 0.2f;
constexpr unsigned LDS_MAIN = 73728;
constexpr unsigned LDS_BYTES = 2 * LDS_MAIN + 64 + 256;

__device__ __forceinline__ unsigned rtid() { unsigned t = threadIdx.x; asm volatile("" : "+v"(t)); return t; }
__device__ __forceinline__ unsigned tidx() { return rtid() & 255u; }
__device__ __forceinline__ unsigned vhalf() { return (unsigned)__builtin_amdgcn_readfirstlane((int)(threadIdx.x >> 8)); }
#define VBID (blockIdx.x * 2u + vhalf())
#define VGRID (gridDim.x * 2u)
#define LAS3 __attribute__((address_space(3)))
extern __shared__ __attribute__((aligned(16))) unsigned char g_smem[];
__device__ __forceinline__ volatile unsigned* wg_slot() { return (volatile unsigned*)(g_smem + 2 * LDS_MAIN + 64 + vhalf() * 128 + 64); }
__device__ __forceinline__ void half_sync() {
    asm volatile("s_waitcnt lgkmcnt(0)" ::: "memory");
    LAS3 unsigned* c = (LAS3 unsigned*)(g_smem + 2 * LDS_MAIN + 64 + vhalf() * 128);
    unsigned target = 0u;
    if ((threadIdx.x & 63u) == 0u) target = (__hip_atomic_fetch_add(c, 1u, __ATOMIC_RELAXED, __HIP_MEMORY_SCOPE_WORKGROUP) & ~3u) + 4u;
    target = (unsigned)__builtin_amdgcn_readfirstlane((int)target);
    while ((unsigned)__builtin_amdgcn_readfirstlane((int)__hip_atomic_load(c, __ATOMIC_RELAXED, __HIP_MEMORY_SCOPE_WORKGROUP)) < target) __builtin_amdgcn_s_sleep(0);
    asm volatile("s_waitcnt lgkmcnt(0)" ::: "memory");
}
__device__ __forceinline__ bf16 f2bf(float f) { u32 u = __float_as_uint(f); u += 0x7FFFu + ((u >> 16) & 1u); return (bf16)(u >> 16); }
typedef __bf16 bf2v_t __attribute__((ext_vector_type(2)));
__device__ __forceinline__ u32 pack_bf2(float lo, float hi) { bf2v_t v; v.x = (__bf16)lo; v.y = (__bf16)hi; return __builtin_bit_cast(u32, v); }
__device__ __forceinline__ float bf2f(bf16 h) { return __uint_as_float(((u32)h) << 16); }
__device__ __forceinline__ float silu_f(float v) { return v / (1.0f + __expf(-v)); }
__device__ __forceinline__ float wave_sum(float v) {
#pragma unroll
    for (int o = 32; o > 0; o >>= 1) v += __shfl_xor(v, o);
    return v;
}
__device__ __forceinline__ float wave_incl_scan(float v, int lane) {
#pragma unroll
    for (int o = 1; o < 64; o <<= 1) { const float t = __shfl_up(v, o); if (lane >= o) v += t; }
    return v;
}
__device__ __forceinline__ float wave_max(float v) {
#pragma unroll
    for (int o = 32; o > 0; o >>= 1) v = fmaxf(v, __shfl_xor(v, o));
    return v;
}

constexpr size_t MiB = 1024 * 1024;
constexpr size_t OFF_CTRL = 0;
constexpr size_t OFF_WINT = 1 * MiB;
constexpr size_t OFF_WOUTT = 7 * MiB;
constexpr size_t OFF_WQT = 9 * MiB;
constexpr size_t OFF_KEYS = 13 * MiB;
constexpr size_t OFF_LAM = 13 * MiB + 512 * 1024;
constexpr size_t OFF_DT = 14 * MiB;
constexpr size_t OFF_SSQ = 15 * MiB;
constexpr size_t OFF_STAT1 = 15 * MiB + 512 * 1024;
constexpr size_t OFF_COLSUM = 13 * MiB + 576 * 1024;
constexpr size_t OFF_BIASQ = 13 * MiB + 592 * 1024;
constexpr size_t OFF_ROPEC = 16 * MiB;
constexpr size_t OFF_ROPES = 20 * MiB;
constexpr size_t OFF_UQ = 24 * MiB;
constexpr size_t OFF_VQ = 40 * MiB;
constexpr size_t OFF_SU = 56 * MiB;
constexpr size_t OFF_SV = 56 * MiB + 65536;
constexpr size_t OFF_R1 = 88 * MiB;
constexpr size_t OFF_R2 = 152 * MiB;
constexpr size_t OFF_QR = OFF_R2;
constexpr size_t OFF_KR = OFF_R2 + 32 * MiB;
constexpr size_t OFF_VTT = OFF_R2 + 64 * MiB;
constexpr size_t OFF_Z = OFF_R2 + 96 * MiB;
constexpr size_t OFF_XBC = OFF_R2 + 128 * MiB;
constexpr size_t OFF_Y1B = OFF_R2 + 128 * MiB;
constexpr size_t OFF_PQ = OFF_R2;
constexpr size_t OFF_R3 = 344 * MiB;
constexpr size_t OFF_XS = OFF_R3;
constexpr size_t OFF_XT = OFF_R3 + 32 * MiB;
constexpr size_t OFF_BT = OFF_R3 + 64 * MiB;
constexpr size_t OFF_CN = OFF_R3 + 80 * MiB;
constexpr size_t OFF_CB = OFF_R3 + 96 * MiB;
constexpr size_t OFF_IDSP = OFF_R3;
constexpr size_t OFF_GATEP = OFF_R3 + 8 * MiB;
constexpr size_t OFF_HQ = OFF_R3 + 24 * MiB;
constexpr size_t OFF_COEF = OFF_R3 + 56 * MiB;
constexpr size_t OFF_CSC = OFF_R3 + 60 * MiB;
constexpr size_t OFF_HSC = OFF_R3 + 72 * MiB;
constexpr size_t OFF_STAT = OFF_R3 + 73 * MiB;
constexpr size_t OFF_Y2B = 420 * MiB;
constexpr size_t OFF_PD = OFF_R2;
constexpr size_t OFF_WL = 488 * MiB;
constexpr size_t OFF_TOT = 489 * MiB;
constexpr size_t OFF_PREV = 456 * MiB;

struct P {
    const float* x; const int* pos; const float* w_in; const float* w_out;
    const float* lq1; const float* lk1; const float* lq2; const float* lk2; const float* subln_g;
    const float* conv_w; const float* conv_b; const float* dt_bias; const float* a_log; const float* d_skip;
    const float* ssd_norm_g; const float* ln1_g; const float* ln1_b; const float* peer_wq; const float* peer_keys;
    const float* peer_u; const float* peer_v; const float* ln2_g; const float* ln2_b;
    float* out; unsigned char* ws;
};
#define WS(T, off) ((T*)(p.ws + (off)))

__device__ __forceinline__ void ph_prep(const P& p, unsigned char* lds) {
    const int tid = tidx(), wid = tid >> 6, lane = tid & 63;
    float* wdt = (float*)lds;
    for (int idx = tid; idx < 8192; idx += 256) { const int k = idx >> 3, j = idx & 7; wdt[j * 1024 + k] = p.w_in[(size_t)k * NIN + 3072 + j]; }
    half_sync();
    const float inv_freq = powf(10000.0f, -(float)(2 * (lane & 31)) / 64.0f);
    for (unsigned tb = (VBID * 4 + wid) * 2; tb < (unsigned)NT; tb += VGRID * 8) {
        f32x4 xv[2][4]; int pos[2];
#pragma unroll
        for (int q = 0; q < 2; ++q) { pos[q] = p.pos[tb + q];
#pragma unroll
            for (int i = 0; i < 4; ++i) xv[q][i] = *(const f32x4*)(p.x + (size_t)(tb + q) * DM + 256 * i + 4 * lane); }
#pragma unroll
        for (int q = 0; q < 2; ++q) {
            const unsigned tok = tb + q;
            bf16* xb = WS(bf16, OFF_R1) + (size_t)tok * DM;
            float acc[8];
#pragma unroll
            for (int j = 0; j < 8; ++j) acc[j] = 0.f;
#pragma unroll
            for (int i = 0; i < 4; ++i) {
                const int k = 256 * i + 4 * lane;
                const f32x4 v = xv[q][i];
                u32x2 o; o.x = pack_bf2(v[0], v[1]); o.y = pack_bf2(v[2], v[3]);
                *(u32x2*)(xb + k) = o;
#pragma unroll
                for (int j = 0; j < 8; ++j) { const f32x4 w = *(const f32x4*)(wdt + j * 1024 + k); acc[j] += v[0] * w[0] + v[1] * w[1] + v[2] * w[2] + v[3] * w[3]; }
            }
#pragma unroll
            for (int j = 0; j < 8; ++j) acc[j] = wave_sum(acc[j]);
            if (lane < 8) {
                float v = 0.f;
#pragma unroll
                for (int j = 0; j < 8; ++j) if (lane == j) v = acc[j];
                v += p.dt_bias[lane];
                WS(float, OFF_DT)[(size_t)tok * 8 + lane] = fmaxf(v, 0.f) + log1pf(expf(-fabsf(v)));
            }
            if (lane < 32) {
                const float ang = (float)pos[q] * inv_freq;
                WS(float, OFF_ROPEC)[(size_t)tok * 32 + lane] = cosf(ang);
                WS(float, OFF_ROPES)[(size_t)tok * 32 + lane] = sinf(ang);
            }
            if (tok == 0 && lane == 0) {
                float s1 = 0.f, s2 = 0.f;
                for (int i = 0; i < 64; ++i) { s1 += p.lq1[i] * p.lk1[i]; s2 += p.lq2[i] * p.lk2[i]; }
                WS(float, OFF_LAM)[0] = expf(s1) - expf(s2) + LAMBDA_INIT;
            }
            if (lane < 2) { WS(float, OFF_SSQ)[(size_t)tok * 2 + lane] = 0.f; WS(float, OFF_STAT1)[(size_t)tok * 2 + lane] = 0.f; }
        }
    }
    half_sync();
    float* tile = (float*)lds;
    for (unsigned t = VBID; t < 1536u; t += VGRID) {
        const float* srcp; bf16* dst; int ld, kt, nt; bool og = false, qg = false;
        if (t < 768u) { srcp = p.w_in; dst = WS(bf16, OFF_WINT); ld = NIN; kt = (int)(t % 16u); nt = (int)(t / 16u); }
        else if (t < 1024u) { const unsigned q = t - 768u; srcp = p.w_out; dst = WS(bf16, OFF_WOUTT); ld = 1024; kt = (int)(q % 16u); nt = (int)(q / 16u); og = true; }
        else { const unsigned q = t - 1024u; srcp = p.peer_wq; dst = WS(bf16, OFF_WQT); ld = 2048; kt = (int)(q % 16u); nt = (int)(q / 16u); qg = true; }
#pragma unroll
        for (int i = 0; i < 4; ++i) {
            const int kr = i * 16 + (tid >> 4), nc = (tid & 15) * 4;
            const f32x4 v = *(const f32x4*)(srcp + (size_t)(kt * 64 + kr) * ld + nt * 64 + nc);
            float sc = 1.0f; if (og && kt * 64 + kr >= 512) sc = p.ssd_norm_g[kt * 64 + kr - 512]; if (qg) sc = p.ln1_g[kt * 64 + kr];
            tile[kr * 65 + nc] = v[0] * sc; tile[kr * 65 + nc + 1] = v[1] * sc; tile[kr * 65 + nc + 2] = v[2] * sc; tile[kr * 65 + nc + 3] = v[3] * sc;
        }
        half_sync();
#pragma unroll
        for (int i = 0; i < 2; ++i) {
            const int item = tid + 256 * i, n = item & 63, kg = item >> 6;
            float e[8];
#pragma unroll
            for (int q = 0; q < 8; ++q) e[q] = tile[(kg * 8 + q) * 65 + n];
            u32x4 o; o.x = pack_bf2(e[0], e[1]); o.y = pack_bf2(e[2], e[3]); o.z = pack_bf2(e[4], e[5]); o.w = pack_bf2(e[6], e[7]);
            int prow = nt * 64 + n;
            if (t < 768u && nt < 16) prow = nt * 64 + ((n & 15) | ((n & 16) << 1) | ((n & 32) >> 1));
            *(u32x4*)(dst + (size_t)prow * 1024 + kt * 64 + kg * 8) = o;
        }
        half_sync();
    }
    for (size_t i = (size_t)VBID * 256 + tid; i < (size_t)8 * 2 * 128 * 128; i += (size_t)VGRID * 256) WS(bf16, OFF_KEYS)[i] = f2bf(p.peer_keys[i]);
    for (unsigned t = VBID; t < 128u; t += VGRID) {
        const int n = (int)t * 16 + (tid & 15), ksl = tid >> 4;
        float cs = 0.f, bs = 0.f;
#pragma unroll 16
        for (int k = ksl * 64; k < ksl * 64 + 64; ++k) { const float w = p.peer_wq[(size_t)k * 2048 + n]; cs += bf2f(f2bf(w * p.ln1_g[k])); bs += w * p.ln1_b[k]; }
        float* red = (float*)lds;
        half_sync();
        red[tid] = cs; red[256 + tid] = bs;
        half_sync();
        if (tid < 16) {
            float c2 = 0.f, b2 = 0.f;
#pragma unroll
            for (int s = 0; s < 16; ++s) { c2 += red[s * 16 + tid]; b2 += red[256 + s * 16 + tid]; }
            WS(float, OFF_COLSUM)[n] = c2; WS(float, OFF_BIASQ)[n] = b2;
        }
        half_sync();
    }
}

__device__ __forceinline__ void k_quant_tables(const P& p, const unsigned item) {
    const int wid = tidx() >> 6, lane = tidx() & 63;
    f32x4 xv[4][4];
#pragma unroll
    for (int q = 0; q < 4; ++q) {
        const unsigned r = (item * 4 + wid) * 4 + q; const bool isv = r >= 16384u; const unsigned row = isv ? r - 16384u : r;
        const float* srcp = (isv ? p.peer_v : p.peer_u) + (size_t)row * 1024 + lane * 16;
#pragma unroll
        for (int i = 0; i < 4; ++i) xv[q][i] = *(const f32x4*)(srcp + 4 * i);
    }
#pragma unroll
    for (int q = 0; q < 4; ++q) {
        const unsigned r = (item * 4 + wid) * 4 + q; const bool isv = r >= 16384u; const unsigned row = isv ? r - 16384u : r;
        float am = 0.f;
#pragma unroll
        for (int i = 0; i < 4; ++i)
#pragma unroll
            for (int e = 0; e < 4; ++e) am = fmaxf(am, fabsf(xv[q][i][e]));
        am = wave_max(am);
        const float inv = am > 0.f ? 127.0f / am : 0.f;
        u32x4 w;
#pragma unroll
        for (int i = 0; i < 4; ++i) { unsigned acc = 0u;
#pragma unroll
            for (int e = 0; e < 4; ++e) { const int qv = (int)rintf(xv[q][i][e] * inv); acc |= ((unsigned)qv & 0xFFu) << (8 * e); }
            w[i] = acc; }
        *(u32x4*)(p.ws + (isv ? OFF_VQ : OFF_UQ) + (size_t)row * 1024 + lane * 16) = w;
        if (lane == 0) WS(float, isv ? OFF_SV : OFF_SU)[row] = am * (1.0f / 127.0f);
    }
}


__device__ __forceinline__ void gemm_stage(const bf16* A, const bf16* Bt, int K, int row0, int col0, int kt, unsigned char* st, int wid, int lane) {
    const int c = (lane & 7) ^ (lane >> 3);
#pragma unroll
    for (int i = 0; i < 4; ++i) {
        const int piece = wid * 4 + i, r = piece * 8 + (lane >> 3);
        __builtin_amdgcn_global_load_lds((const u32*)(A + (size_t)(row0 + r) * K + kt * 64 + c * 8), (u32*)(st + piece * 1024 + lane * 16), 16, 0, 0);
        __builtin_amdgcn_global_load_lds((const u32*)(Bt + (size_t)(col0 + r) * K + kt * 64 + c * 8), (u32*)(st + 16384 + piece * 1024 + lane * 16), 16, 0, 0);
    }
}
template <bool RESC, class Epi>
__device__ __forceinline__ void gemm_tile(const bf16* A, const bf16* Bt, int K, int row0, int col0, unsigned char* lds, const float* ssq, const Epi& epi, bool first, int nrow0, int ncol0) {
    const int wid = tidx() >> 6, lane = tidx() & 63, wr = wid >> 1, wc = wid & 1, fr = lane & 15, fq = lane >> 4;
    f32x4 acc[4][4];
#pragma unroll
    for (int m = 0; m < 4; ++m)
#pragma unroll
        for (int n = 0; n < 4; ++n) acc[m][n] = (f32x4){0.f, 0.f, 0.f, 0.f};
    float r0[4], r1[4];
    if (RESC) {
#pragma unroll
        for (int m = 0; m < 4; ++m) { const f32x2 s = *(const f32x2*)(ssq + (size_t)(row0 + wr * 64 + m * 16 + fr) * 2); r0[m] = rsqrtf(s.x * (1.0f / 256.0f) + 1e-5f); r1[m] = rsqrtf(s.y * (1.0f / 256.0f) + 1e-5f); }
    }
    const int nt = K / 64;
    if (first) gemm_stage(A, Bt, K, row0, col0, 0, lds, wid, lane);
    for (int kt = 0; kt < nt; ++kt) {
        unsigned char* cur = lds + (kt & 1) * 32768;
        asm volatile("s_waitcnt vmcnt(0)" ::: "memory");
        half_sync();
        if (kt + 1 < nt) gemm_stage(A, Bt, K, row0, col0, kt + 1, lds + ((kt + 1) & 1) * 32768, wid, lane);
        else if (nrow0 >= 0) gemm_stage(A, Bt, K, nrow0, ncol0, 0, lds, wid, lane);
        if (RESC && (kt == 8 || kt == 12)) {
#pragma unroll
            for (int m = 0; m < 4; ++m) { const float f = (kt == 8) ? (1.0f / r0[m]) : (r0[m] / r1[m]);
#pragma unroll
                for (int n = 0; n < 4; ++n) acc[m][n] *= f; }
        }
        bf16x8 af[2][4], bfr[2][4];
#pragma unroll
        for (int ks = 0; ks < 2; ++ks) {
            const int coff = ((ks * 4 + fq) ^ (fr & 7)) * 16;
#pragma unroll
            for (int m = 0; m < 4; ++m) af[ks][m] = *(const bf16x8*)(cur + (wr * 64 + m * 16 + fr) * 128 + coff);
#pragma unroll
            for (int n = 0; n < 4; ++n) bfr[ks][n] = *(const bf16x8*)(cur + 16384 + (wc * 64 + n * 16 + fr) * 128 + coff);
        }
        __builtin_amdgcn_sched_barrier(0);
#pragma unroll
        for (int ks = 0; ks < 2; ++ks)
#pragma unroll
            for (int m = 0; m < 4; ++m)
#pragma unroll
                for (int n = 0; n < 4; ++n) acc[m][n] = __builtin_amdgcn_mfma_f32_16x16x32_bf16(bfr[ks][n], af[ks][m], acc[m][n], 0, 0, 0);
        __builtin_amdgcn_sched_barrier(0);
    }
    if (RESC) {
#pragma unroll
        for (int m = 0; m < 4; ++m)
#pragma unroll
            for (int n = 0; n < 4; ++n) acc[m][n] *= r1[m];
    }
    epi(acc, row0 + wr * 64 + fr, col0 + wc * 64 + 4 * fq);
    half_sync();
}
__device__ __forceinline__ void gemm_tile_coord(unsigned t, int nN, int& pm, int& pn) {
    const unsigned x = (t >> 1) & 7u, li = ((t >> 4) << 1) | (t & 1u), per_g = 32u * 8u, ng = li / per_g, rem = li % per_g;
    pm = (int)(x * 32u + rem / 8u); pn = (int)(ng * 8u + rem % 8u); (void)nN;
}
struct EpiInProj {
    const P& p;
    __device__ __forceinline__ void operator()(const f32x4 (&acc)[4][4], int row, int col) const {
        const int tile_col0 = col & ~127;
        if (tile_col0 < 1024) {
            const bool isq = tile_col0 < 512;
            bf16* dst = WS(bf16, isq ? OFF_QR : OFF_KR);
            const int hc0 = (col & 511) & ~63, i0 = col & 63;
            const float qs = isq ? 0.125f * 1.4426950408889634f : 1.0f;
#pragma unroll
            for (int m = 0; m < 4; ++m) {
                const size_t tok = (size_t)(row + 16 * m);
#pragma unroll
                for (int n = 0; n < 2; ++n) {
                    const int i = i0 + 16 * n;
                    const f32x4 cs = *(const f32x4*)(WS(float, OFF_ROPEC) + tok * 32 + i), sn = *(const f32x4*)(WS(float, OFF_ROPES) + tok * 32 + i);
                    const f32x4 x1 = acc[m][n], x2 = acc[m][n + 2];
                    const f32x4 o1 = (x1 * cs - x2 * sn) * qs, o2 = (x2 * cs + x1 * sn) * qs;
                    uint2 w1, w2; w1.x = pack_bf2(o1[0], o1[1]); w1.y = pack_bf2(o1[2], o1[3]); w2.x = pack_bf2(o2[0], o2[1]); w2.y = pack_bf2(o2[2], o2[3]);
                    *(uint2*)(dst + tok * 512 + hc0 + i) = w1; *(uint2*)(dst + tok * 512 + hc0 + i + 32) = w2;
                }
            }
        } else if (tile_col0 < 1536) {
#pragma unroll
            for (int m = 0; m < 4; ++m) {
                const int tok = row + 16 * m, b = tok >> 11, s = tok & 2047;
#pragma unroll
                for (int n = 0; n < 4; ++n)
#pragma unroll
                    for (int j = 0; j < 4; ++j) { const int c = col - 1024 + 16 * n + j; WS(bf16, OFF_VTT)[((size_t)b * 512 + c) * SEQ + s] = f2bf(acc[m][n][j]); }
            }
        } else {
            bf16* dst; int ld, c0;
            if (tile_col0 < 2048) { dst = WS(bf16, OFF_Z); ld = 512; c0 = col - 1536; } else { dst = WS(bf16, OFF_XBC); ld = 1024; c0 = col - 2048; }
#pragma unroll
            for (int m = 0; m < 4; ++m)
#pragma unroll
                for (int n = 0; n < 4; ++n) { uint2 w; w.x = pack_bf2(acc[m][n][0], acc[m][n][1]); w.y = pack_bf2(acc[m][n][2], acc[m][n][3]); *(uint2*)(dst + (size_t)(row + 16 * m) * ld + c0 + 16 * n) = w; }
        }
    }
};
struct EpiOutProj {
    const P& p;
    __device__ __forceinline__ void operator()(const f32x4 (&acc)[4][4], int row, int col) const {
#pragma unroll
        for (int m = 0; m < 4; ++m) {
            float s1 = 0.f, s2 = 0.f;
#pragma unroll
            for (int n = 0; n < 4; ++n) {
                const size_t o = (size_t)(row + 16 * m) * 1024 + col + 16 * n;
                const f32x4 y = *(const f32x4*)(p.x + o) * ALPHA + acc[m][n];
                s1 += (y[0] + y[1]) + (y[2] + y[3]); s2 += (y[0] * y[0] + y[1] * y[1]) + (y[2] * y[2] + y[3] * y[3]);
                u32x2 w; w.x = pack_bf2(y[0], y[1]); w.y = pack_bf2(y[2], y[3]);
                *(u32x2*)(WS(bf16, OFF_Y1B) + o) = w;
            }
            s1 += __shfl_xor(s1, 16); s1 += __shfl_xor(s1, 32); s2 += __shfl_xor(s2, 16); s2 += __shfl_xor(s2, 32);
            if ((tidx() & 63u) < 16u) { atomicAdd(WS(float, OFF_STAT1) + (size_t)(row + 16 * m) * 2, s1); atomicAdd(WS(float, OFF_STAT1) + (size_t)(row + 16 * m) * 2 + 1, s2); }
        }
    }
};
struct EpiPeerQ {
    const P& p;
    __device__ __forceinline__ void operator()(const f32x4 (&acc)[4][4], int row, int col) const {
        f32x4 cs[4], bq[4];
#pragma unroll
        for (int n = 0; n < 4; ++n) { cs[n] = *(const f32x4*)(WS(float, OFF_COLSUM) + col + 16 * n); bq[n] = *(const f32x4*)(WS(float, OFF_BIASQ) + col + 16 * n); }
#pragma unroll
        for (int m = 0; m < 4; ++m) {
            const f32x2 st = *(const f32x2*)(WS(float, OFF_STAT1) + (size_t)(row + 16 * m) * 2);
            const float mu = st.x * (1.0f / 1024.0f), rs = rsqrtf(fmaxf(st.y * (1.0f / 1024.0f) - mu * mu, 0.f) + 1e-5f);
#pragma unroll
            for (int n = 0; n < 4; ++n) {
                const f32x4 q = (acc[m][n] - cs[n] * mu) * rs + bq[n];
                u32x2 w; w.x = pack_bf2(q[0], q[1]); w.y = pack_bf2(q[2], q[3]);
                *(u32x2*)(WS(bf16, OFF_PQ) + (size_t)(row + 16 * m) * 2048 + col + 16 * n) = w;
            }
        }
    }
};
__device__ __forceinline__ void ph_inproj(const P& p, unsigned char* lds) {
    const EpiInProj epi{p};
    for (unsigned t = VBID; t < 256u * 24u; t += VGRID) { int pm, pn, npm = -1, npn = 0; gemm_tile_coord(t, 24, pm, pn); if (t + VGRID < 256u * 24u) gemm_tile_coord(t + VGRID, 24, npm, npn); gemm_tile<false>(WS(bf16, OFF_R1), WS(bf16, OFF_WINT), 1024, pm * 128, pn * 128, lds, nullptr, epi, t == VBID, npm * 128, npn * 128); }
}
__device__ __forceinline__ void ph_outproj(const P& p, unsigned char* lds) {
    const EpiOutProj epi{p};
    for (unsigned t = VBID; t < 256u * 8u; t += VGRID) { int pm, pn, npm = -1, npn = 0; gemm_tile_coord(t, 8, pm, pn); if (t + VGRID < 256u * 8u) gemm_tile_coord(t + VGRID, 8, npm, npn); gemm_tile<true>(WS(bf16, OFF_R1), WS(bf16, OFF_WOUTT), 1024, pm * 128, pn * 128, lds, WS(float, OFF_SSQ), epi, t == VBID, npm * 128, npn * 128); }
}
__device__ __forceinline__ void ph_peerq(const P& p, unsigned char* lds) {
    const EpiPeerQ epi{p};
    for (unsigned t = VBID; t < 256u * 16u; t += VGRID) { int pm, pn, npm = -1, npn = 0; gemm_tile_coord(t, 16, pm, pn); if (t + VGRID < 256u * 16u) gemm_tile_coord(t + VGRID, 16, npm, npn); gemm_tile<false>(WS(bf16, OFF_Y1B), WS(bf16, OFF_WQT), 1024, pm * 128, pn * 128, lds, nullptr, epi, t == VBID, npm * 128, npn * 128); }
}


namespace pg8 {
#define PG8_LAS __attribute__((address_space(3)))
typedef unsigned short bf16_t;
constexpr int BM = 256, BK = 64, HALF = 128, HTB = HALF * BK * 2  , STAGE_BYTES = 8 * HTB, NXCD = 8, WGM = 8;

__host__ __device__ __forceinline__ int lds_byte(int r, int c) { const int st = (r >> 4) * 2 + (c >> 5), rr = r & 15, cc = c & 31, ob = rr * 64 + cc * 2; return st * 1024 + (ob ^ (((ob >> 9) & 1) << 5)); }
__host__ __device__ __forceinline__ void stage_rc(int b, int& R, int& C) { const int st = b / 1024, sb = b % 1024, swz = sb ^ (((sb >> 9) & 1) << 5); R = (st >> 1) * 16 + swz / 64; C = (st & 1) * 32 + (swz % 64) / 2; }
__host__ __device__ __forceinline__ int perm32(int rho) { const int n = rho >> 4, i = rho & 15; return 8 * (i >> 2) + 4 * n + (i & 3); }

struct Unit { int pm, pn; };
struct Gemm { const bf16_t* A; const bf16_t* Bt; int M, N, K; };

struct StaticOrder {
    int nM, nN, nwg, G, c;
    __host__ __device__ void init(int M, int N, int G_, int c_) { nM = M / BM; nN = N / BM; nwg = nM * nN; G = G_; c = c_; }
    __host__ __device__ bool next(int i, Unit& u) const {
        const long L = (long)i * G + c; if (L >= nwg) return false;
        int wgid = (int)L; { const int q = nwg / NXCD, r = nwg % NXCD, xcd = wgid % NXCD, off = wgid / NXCD; wgid = (xcd < r ? xcd * (q + 1) : r * (q + 1) + (xcd - r) * q) + off; }
        const int nig = WGM * nN, gid = wgid / nig, fm = gid * WGM, gsz = (nM - fm) < WGM ? (nM - fm) : WGM;
        u.pm = fm + ((wgid % nig) % gsz); u.pn = (wgid % nig) / gsz; return true;
    }
    __device__ __forceinline__ void a_ready(const Unit&) const {}
    __device__ __forceinline__ void done(const Unit&) const {}
};
template <class Epi, class Sched>
__device__ __forceinline__ void gemm_phase(PG8_LAS unsigned char* lds, const Gemm g, const Sched& S, const Epi& E) {
    const int tid = threadIdx.x, wid = __builtin_amdgcn_readfirstlane(tid >> 6), lane = tid & 63, wr = wid >> 2, wc = wid & 3, fr = lane & 15, fq = lane >> 4;
    const int K = g.K, nt = K / BK;
    unsigned voffA[2], voffB[2];
#pragma unroll
    for (int i = 0; i < 2; ++i) { int R, C; stage_rc(tid * 16 + i * 8192, R, C); const int Rb = Epi::PERM ? ((R & ~31) + perm32(R & 31)) : R;
        voffA[i] = (unsigned)(R * K + C) * 2u; voffB[i] = (unsigned)(Rb * K + C) * 2u; }
    const size_t kstep = (size_t)(BK * 2);
    const size_t hstep = (size_t)HALF * K * 2;
    const size_t tstep = 2 * hstep;
    const unsigned ldsw = (unsigned)wid * 1024u;
    const int aoff = lds_byte(wr * 64 + fr, fq * 8), boff = lds_byte(wc * 32 + fr, fq * 8);
#define PG8_SA(b, h) (((b) * 2 + (h)) * HTB)
#define PG8_SB(b, h) ((4 + (b) * 2 + (h)) * HTB)
#define PG8_STAGE(bufoff, gbase, voff) do { _Pragma("unroll") for (int _i = 0; _i < 2; ++_i) \
        __builtin_amdgcn_global_load_lds((const unsigned*)((const char*)(gbase) + (voff)[_i]), (PG8_LAS unsigned*)(lds + (bufoff) + ldsw + _i * 8192), 16, 0, 0); } while (0)
#define PG8_LDA(dst, b, h) do { _Pragma("unroll") for (int m = 0; m < 4; ++m) _Pragma("unroll") for (int k = 0; k < 2; ++k) dst[m][k] = *(const PG8_LAS bf16x8*)(lds + PG8_SA(b, h) + aoff + m * 2048 + k * 1024); } while (0)
#define PG8_LDB(dst, b, h) do { _Pragma("unroll") for (int n = 0; n < 2; ++n) _Pragma("unroll") for (int k = 0; k < 2; ++k) dst[n][k] = *(const PG8_LAS bf16x8*)(lds + PG8_SB(b, h) + boff + n * 2048 + k * 1024); } while (0)
#define PG8_MMA(ai, bj, At, Bt) do { __builtin_amdgcn_s_setprio(1); _Pragma("unroll") for (int m = 0; m < 4; ++m) _Pragma("unroll") for (int n = 0; n < 2; ++n) _Pragma("unroll") for (int k = 0; k < 2; ++k) \
        acc[ai][bj][m][n] = __builtin_amdgcn_mfma_f32_16x16x32_bf16(Bt[n][k], At[m][k], acc[ai][bj][m][n], 0, 0, 0); __builtin_amdgcn_s_setprio(0); } while (0)
#define PG8_WAIT_V(n) asm volatile("s_waitcnt vmcnt(" #n ")" ::: "memory")
#define PG8_WAIT_L(n) asm volatile("s_waitcnt lgkmcnt(" #n ")" ::: "memory")
#define PG8_BAR __builtin_amdgcn_s_barrier()
#define PG8_SCHED __builtin_amdgcn_sched_barrier(0)
    Unit cur, nxt; int ui = 0;
    if (!S.next(0, cur)) return;
    f32x4 acc[2][2][4][2];
#pragma unroll
    for (int a = 0; a < 2; ++a)
#pragma unroll
        for (int b = 0; b < 2; ++b)
#pragma unroll
            for (int m = 0; m < 4; ++m)
#pragma unroll
                for (int n = 0; n < 2; ++n) acc[a][b][m][n] = (f32x4){0.f, 0.f, 0.f, 0.f};
    bf16x8 At[4][2], B0[2][2], B1[2][2];
    const char* cA = (const char*)g.A + (size_t)cur.pm * tstep; const char* cB = (const char*)g.Bt + (size_t)cur.pn * tstep;
    S.a_ready(cur);
    PG8_STAGE(PG8_SB(0, 0), cB, voffB); PG8_STAGE(PG8_SA(0, 0), cA, voffA); PG8_STAGE(PG8_SB(0, 1), cB + hstep, voffB); PG8_STAGE(PG8_SA(0, 1), cA + hstep, voffA);
    if (wr == 1) PG8_BAR;
    PG8_WAIT_V(4); PG8_BAR;
    PG8_STAGE(PG8_SB(1, 0), cB + kstep, voffB); PG8_STAGE(PG8_SA(1, 0), cA + kstep, voffA); PG8_STAGE(PG8_SB(1, 1), cB + hstep + kstep, voffB);
    PG8_WAIT_V(6); PG8_BAR;
    for (;;) {
        const bool has_next = S.next(ui + 1, nxt);
        const char* nA = has_next ? (const char*)g.A + (size_t)nxt.pm * tstep : cA; const char* nB = has_next ? (const char*)g.Bt + (size_t)nxt.pn * tstep : cB;
        for (int t = 0; t < nt; t += 2) {
            const bool last = (t == nt - 2);
            const char* a1 = cA + (size_t)(t + 1) * kstep;
            const char* a2 = last ? nA : cA + (size_t)(t + 2) * kstep; const char* b2 = last ? nB : cB + (size_t)(t + 2) * kstep;
            const char* a3 = a2 + kstep; const char* b3 = b2 + kstep;
            if (last && has_next) S.a_ready(nxt);
            PG8_LDB(B0, 0, 0); PG8_SCHED; PG8_LDA(At, 0, 0); PG8_STAGE(PG8_SA(1, 1), a1 + hstep, voffA);
            PG8_WAIT_L(8); PG8_BAR; PG8_WAIT_L(0); PG8_MMA(0, 0, At, B0); PG8_BAR; PG8_SCHED;
            PG8_LDB(B1, 0, 1); PG8_STAGE(PG8_SB(0, 0), b2, voffB);
            PG8_BAR; PG8_WAIT_L(0); PG8_MMA(0, 1, At, B1); PG8_BAR;
            PG8_LDA(At, 0, 1); PG8_STAGE(PG8_SA(0, 0), a2, voffA);
            PG8_BAR; PG8_WAIT_L(0); PG8_MMA(1, 0, At, B0); PG8_BAR; PG8_SCHED;
            PG8_STAGE(PG8_SB(0, 1), b2 + hstep, voffB);
            PG8_WAIT_V(6); PG8_BAR; PG8_MMA(1, 1, At, B1); PG8_BAR;
            PG8_LDB(B0, 1, 0); PG8_SCHED; PG8_LDA(At, 1, 0); PG8_STAGE(PG8_SA(0, 1), a2 + hstep, voffA);
            PG8_WAIT_L(8); PG8_BAR; PG8_WAIT_L(0); PG8_MMA(0, 0, At, B0); PG8_BAR; PG8_SCHED;
            PG8_LDB(B1, 1, 1); PG8_STAGE(PG8_SB(1, 0), b3, voffB);
            PG8_BAR; PG8_WAIT_L(0); PG8_MMA(0, 1, At, B1); PG8_BAR;
            PG8_LDA(At, 1, 1); PG8_STAGE(PG8_SA(1, 0), a3, voffA);
            PG8_BAR; PG8_WAIT_L(0); PG8_MMA(1, 0, At, B0); PG8_BAR; PG8_SCHED;
            PG8_STAGE(PG8_SB(1, 1), b3 + hstep, voffB);
            PG8_WAIT_V(6); PG8_BAR; PG8_MMA(1, 1, At, B1); PG8_BAR;
        }
        if constexpr (!Epi::AFTER_DRAIN) { E(acc, cur, wr, wc, fr, fq); S.done(cur); }
        if (!has_next) break;
#pragma unroll
        for (int a = 0; a < 2; ++a)
#pragma unroll
            for (int b = 0; b < 2; ++b)
#pragma unroll
                for (int m = 0; m < 4; ++m)
#pragma unroll
                    for (int n = 0; n < 2; ++n) acc[a][b][m][n] = (f32x4){0.f, 0.f, 0.f, 0.f};
        cur = nxt; cA = nA; cB = nB; ++ui;
    }
    PG8_WAIT_V(0);
    if (wr == 0) PG8_BAR;
    PG8_BAR;
    if constexpr (Epi::AFTER_DRAIN) { E.fused(acc, cur, wr, wc, fr, fq, lds, wid, lane); S.done(cur); }
#undef PG8_SA
#undef PG8_SB
#undef PG8_STAGE
#undef PG8_LDA
#undef PG8_LDB
#undef PG8_MMA
#undef PG8_WAIT_V
#undef PG8_WAIT_L
#undef PG8_BAR
#undef PG8_SCHED
}
}

struct EpiInProj8 {
    static constexpr bool PERM = false, AFTER_DRAIN = false;
    const P& p;
    __device__ __forceinline__ void operator()(const f32x4 (&acc)[2][2][4][2], const pg8::Unit& u, int wr, int wc, int fr, int fq) const {
        const int colt = u.pn * 256;
        if (colt < 1024) {
            const bool isq = colt < 512;
            bf16* dst = WS(bf16, isq ? OFF_QR : OFF_KR);
            const float qs = isq ? 0.125f * 1.4426950408889634f : 1.0f;
            const int i0 = 16 * (wc & 1) + 4 * fq;
#pragma unroll
            for (int ai = 0; ai < 2; ++ai)
#pragma unroll
                for (int m = 0; m < 4; ++m) {
                    const size_t tok = (size_t)u.pm * 256 + ai * 128 + wr * 64 + m * 16 + fr;
                    const f32x4 cs = *(const f32x4*)(WS(float, OFF_ROPEC) + tok * 32 + i0), sn = *(const f32x4*)(WS(float, OFF_ROPES) + tok * 32 + i0);
#pragma unroll
                    for (int bj = 0; bj < 2; ++bj) {
                        const int hb = ((colt + bj * 128 + 32 * wc) & 511) & ~63;
                        const f32x4 x1 = acc[ai][bj][m][0], x2 = acc[ai][bj][m][1];
                        const f32x4 o1 = (x1 * cs - x2 * sn) * qs, o2 = (x2 * cs + x1 * sn) * qs;
                        u32x2 w1, w2; w1.x = pack_bf2(o1[0], o1[1]); w1.y = pack_bf2(o1[2], o1[3]); w2.x = pack_bf2(o2[0], o2[1]); w2.y = pack_bf2(o2[2], o2[3]);
                        *(u32x2*)(dst + tok * 512 + hb + i0) = w1; *(u32x2*)(dst + tok * 512 + hb + i0 + 32) = w2;
                    }
                }
        } else if (colt < 1536) {
#pragma unroll
            for (int ai = 0; ai < 2; ++ai)
#pragma unroll
                for (int m = 0; m < 4; ++m) {
                    const int tok = u.pm * 256 + ai * 128 + wr * 64 + m * 16 + fr, b = tok >> 11, s = tok & 2047;
#pragma unroll
                    for (int bj = 0; bj < 2; ++bj)
#pragma unroll
                        for (int n = 0; n < 2; ++n)
#pragma unroll
                            for (int j = 0; j < 4; ++j) { const int c = colt - 1024 + bj * 128 + 32 * wc + 16 * n + 4 * fq + j; WS(bf16, OFF_VTT)[((size_t)b * 512 + c) * SEQ + s] = f2bf(acc[ai][bj][m][n][j]); }
                }
        } else {
            bf16* dst; int ld, c0;
            if (colt < 2048) { dst = WS(bf16, OFF_Z); ld = 512; c0 = colt - 1536; } else { dst = WS(bf16, OFF_XBC); ld = 1024; c0 = colt - 2048; }
#pragma unroll
            for (int ai = 0; ai < 2; ++ai)
#pragma unroll
                for (int m = 0; m < 4; ++m) {
                    const size_t tok = (size_t)u.pm * 256 + ai * 128 + wr * 64 + m * 16 + fr;
#pragma unroll
                    for (int bj = 0; bj < 2; ++bj)
#pragma unroll
                        for (int n = 0; n < 2; ++n) { u32x2 w; w.x = pack_bf2(acc[ai][bj][m][n][0], acc[ai][bj][m][n][1]); w.y = pack_bf2(acc[ai][bj][m][n][2], acc[ai][bj][m][n][3]);
                            *(u32x2*)(dst + tok * ld + c0 + bj * 128 + 32 * wc + 16 * n + 4 * fq) = w; }
                }
        }
    }
};
struct EpiPeerQ8 {
    static constexpr bool PERM = false, AFTER_DRAIN = false;
    const P& p;
    __device__ __forceinline__ void operator()(const f32x4 (&acc)[2][2][4][2], const pg8::Unit& u, int wr, int wc, int fr, int fq) const {
        const int col0 = u.pn * 256 + 32 * wc + 4 * fq;
        f32x4 cs[2][2], bq[2][2];
#pragma unroll
        for (int bj = 0; bj < 2; ++bj)
#pragma unroll
            for (int n = 0; n < 2; ++n) { cs[bj][n] = *(const f32x4*)(WS(float, OFF_COLSUM) + col0 + bj * 128 + 16 * n); bq[bj][n] = *(const f32x4*)(WS(float, OFF_BIASQ) + col0 + bj * 128 + 16 * n); }
#pragma unroll
        for (int ai = 0; ai < 2; ++ai)
#pragma unroll
            for (int m = 0; m < 4; ++m) {
                const size_t tok = (size_t)u.pm * 256 + ai * 128 + wr * 64 + m * 16 + fr;
                const f32x2 st = *(const f32x2*)(WS(float, OFF_STAT1) + tok * 2);
                const float mu = st.x * (1.0f / 1024.0f), rs = rsqrtf(fmaxf(st.y * (1.0f / 1024.0f) - mu * mu, 0.f) + 1e-5f);
#pragma unroll
                for (int bj = 0; bj < 2; ++bj)
#pragma unroll
                    for (int n = 0; n < 2; ++n) {
                        const f32x4 q = (acc[ai][bj][m][n] - cs[bj][n] * mu) * rs + bq[bj][n];
                        u32x2 w; w.x = pack_bf2(q[0], q[1]); w.y = pack_bf2(q[2], q[3]);
                        *(u32x2*)(WS(bf16, OFF_PQ) + tok * 2048 + col0 + bj * 128 + 16 * n) = w;
                    }
            }
    }
};
__device__ __forceinline__ float quad_max(float v) {
    const auto r = __builtin_amdgcn_permlane16_swap(__float_as_uint(v), __float_as_uint(v), false, false);
    v = fmaxf(__uint_as_float(r[0]), __uint_as_float(r[1]));
    const auto q = __builtin_amdgcn_permlane32_swap(__float_as_uint(v), __float_as_uint(v), false, false);
    return fmaxf(__uint_as_float(q[0]), __uint_as_float(q[1]));
}
__device__ __forceinline__ float quad_sum(float v) {
    const auto r = __builtin_amdgcn_permlane16_swap(__float_as_uint(v), __float_as_uint(v), false, false);
    v = __uint_as_float(r[0]) + __uint_as_float(r[1]);
    const auto q = __builtin_amdgcn_permlane32_swap(__float_as_uint(v), __float_as_uint(v), false, false);
    return __uint_as_float(q[0]) + __uint_as_float(q[1]);
}

__device__ __forceinline__ void ph_ssd_finalize(const P& p) {
    const int tid = tidx(), wid = tid >> 6, lane = tid & 63;
    for (unsigned tb = (VBID * 4 + wid) * 4; tb < (unsigned)NT; tb += VGRID * 16) {
        f32x2 sq[4]; u32x4 v[4];
#pragma unroll
        for (int q = 0; q < 4; ++q) { sq[q] = *(const f32x2*)(WS(float, OFF_SSQ) + (size_t)(tb + q) * 2); v[q] = *(const u32x4*)(WS(bf16, OFF_R1) + (size_t)(tb + q) * 1024 + 512 + lane * 8); }
#pragma unroll
        for (int q = 0; q < 4; ++q) {
            const float r = rsqrtf((lane < 32 ? sq[q].x : sq[q].y) * (1.0f / 256.0f) + 1e-5f);
            u32x4 o;
#pragma unroll
            for (int k = 0; k < 4; ++k) o[k] = pack_bf2(__uint_as_float(v[q][k] << 16) * r, __uint_as_float(v[q][k] & 0xFFFF0000u) * r);
            *(u32x4*)(WS(bf16, OFF_R1) + (size_t)(tb + q) * 1024 + 512 + lane * 8) = o;
        }
    }
}
struct EpiOutProj8 {
    static constexpr bool PERM = false, AFTER_DRAIN = false;
    const P& p;
    __device__ __forceinline__ void operator()(const f32x4 (&acc)[2][2][4][2], const pg8::Unit& u, int wr, int wc, int fr, int fq) const {
        const int col0 = u.pn * 256 + 32 * wc + 4 * fq;
#pragma unroll
        for (int ai = 0; ai < 2; ++ai)
#pragma unroll
            for (int m = 0; m < 4; ++m) {
                const size_t tok = (size_t)u.pm * 256 + ai * 128 + wr * 64 + m * 16 + fr;
                float s1 = 0.f, s2 = 0.f;
#pragma unroll
                for (int bj = 0; bj < 2; ++bj)
#pragma unroll
                    for (int n = 0; n < 2; ++n) {
                        const size_t o = tok * 1024 + col0 + bj * 128 + 16 * n;
                        const f32x4 y = *(const f32x4*)(p.x + o) * ALPHA + acc[ai][bj][m][n];
                        s1 += (y[0] + y[1]) + (y[2] + y[3]); s2 += (y[0] * y[0] + y[1] * y[1]) + (y[2] * y[2] + y[3] * y[3]);
                        u32x2 w; w.x = pack_bf2(y[0], y[1]); w.y = pack_bf2(y[2], y[3]);
                        *(u32x2*)(WS(bf16, OFF_Y1B) + o) = w;
                    }
                s1 = quad_sum(s1); s2 = quad_sum(s2);
                if (fq == 0) { atomicAdd(WS(float, OFF_STAT1) + tok * 2, s1); atomicAdd(WS(float, OFF_STAT1) + tok * 2 + 1, s2); }
            }
    }
};
__device__ __forceinline__ void ph_outproj8(const P& p) {
    const pg8::Gemm g{WS(bf16, OFF_R1), WS(bf16, OFF_WOUTT), NT, 1024, 1024};
    pg8::StaticOrder S; S.init(NT, 1024, (int)gridDim.x, (int)blockIdx.x);
    const EpiOutProj8 E{p};
    pg8::gemm_phase((PG8_LAS unsigned char*)g_smem, g, S, E);
}

__device__ __forceinline__ void ph_inproj8(const P& p) {
    const pg8::Gemm g{WS(bf16, OFF_R1), WS(bf16, OFF_WINT), NT, 3072, 1024};
    pg8::StaticOrder S; S.init(NT, 3072, (int)gridDim.x, (int)blockIdx.x);
    const EpiInProj8 E{p};
    pg8::gemm_phase((PG8_LAS unsigned char*)g_smem, g, S, E);
}
__device__ __forceinline__ void ph_peerq8(const P& p) {
    const pg8::Gemm g{WS(bf16, OFF_Y1B), WS(bf16, OFF_WQT), NT, 2048, 1024};
    pg8::StaticOrder S; S.init(NT, 2048, (int)gridDim.x, (int)blockIdx.x);
    const EpiPeerQ8 E{p};
    pg8::gemm_phase((PG8_LAS unsigned char*)g_smem, g, S, E);
}

__device__ __forceinline__ unsigned queue_next(unsigned* ctr, volatile unsigned* slot) {
    half_sync();
    if (tidx() == 0) *slot = atomicAdd(ctr, 1u);
    half_sync();
    return *slot;
}
typedef float f32x16 __attribute__((ext_vector_type(16)));
typedef __bf16 bf2_t __attribute__((ext_vector_type(2)));
__device__ __forceinline__ void ce_desc(float& a, float& b) {
    float hi, lo;
    asm("v_max_f32 %0, %1, %2" : "=v"(hi) : "v"(a), "v"(b));
    asm("v_min_f32 %0, %1, %2" : "=v"(lo) : "v"(a), "v"(b));
    a = hi; b = lo;
}
__device__ __forceinline__ void sort16_desc(float (&v)[16]) {
#pragma unroll
    for (int k = 2; k <= 16; k <<= 1)
#pragma unroll
        for (int j = k >> 1; j > 0; j >>= 1)
#pragma unroll
            for (int i = 0; i < 16; ++i) { const int l = i ^ j; if (l > i) { if ((i & k) == 0) ce_desc(v[i], v[l]); else ce_desc(v[l], v[i]); } }
}
__device__ __forceinline__ void merge16_desc(float (&x)[16], const float (&y)[16]) {
#pragma unroll
    for (int i = 0; i < 16; ++i) { float m; asm("v_max_f32 %0, %1, %2" : "=v"(m) : "v"(x[i]), "v"(y[15 - i])); x[i] = m; }
#pragma unroll
    for (int j = 8; j > 0; j >>= 1)
#pragma unroll
        for (int i = 0; i < 16; ++i) { const int l = i ^ j; if (l > i) ce_desc(x[i], x[l]); }
}
__device__ __forceinline__ void top16_of_64(const float (&v)[64], float (&out)[16]) {
#pragma unroll
    for (int i = 0; i < 16; ++i) out[i] = v[i];
    sort16_desc(out);
#pragma unroll
    for (int g = 1; g < 4; ++g) {
        float t[16];
#pragma unroll
        for (int i = 0; i < 16; ++i) t[i] = v[16 * g + i];
        sort16_desc(t);
        merge16_desc(out, t);
    }
}
struct CandTab { int i[64], j[64]; };
constexpr CandTab make_cand() {
    CandTab t{}; int n = 0;
    for (int i = 0; i < 16; ++i) for (int j = 0; j < 16; ++j) if ((i + 1) * (j + 1) <= 16) { t.i[n] = i; t.j[n] = j; ++n; }
    for (; n < 64; ++n) { t.i[n] = -1; t.j[n] = -1; }
    return t;
}
__device__ __forceinline__ float gelu_erf(float x) { return 0.5f * x * (1.0f + erff(x * 0.70710678118654752f)); }

__device__ __forceinline__ void peer_route_unit(const P& p, unsigned unit, unsigned char* lds) {
    const int tid = tidx(), wid = tid >> 6, lane = tid & 63, t = lane & 31, half = lane >> 5;
    float* RES = (float*)lds + wid * 2048;
    unsigned short* IDS = (unsigned short*)(lds + 32768);
    float* GATE = (float*)(lds + 40960);
    const int tok0 = (int)unit * 32;
    for (int hcl = 0; hcl < 4; ++hcl) {
        const int hl = hcl >> 1, c = hcl & 1, hc = (2 * wid + hl) * 2 + c;
        const bf16* kb = WS(bf16, OFF_KEYS) + ((size_t)hc * 128 + t) * 128 + 8 * half;
        const bf16* qb = WS(bf16, OFF_PQ) + (size_t)(tok0 + t) * 2048 + hc * 128 + 8 * half;
        bf16x8 qf[8], kf[3][8];
#pragma unroll
        for (int ks = 0; ks < 8; ++ks) qf[ks] = *(const bf16x8*)(qb + ks * 16);
#pragma unroll
        for (int ks = 0; ks < 8; ++ks) kf[0][ks] = *(const bf16x8*)(kb + ks * 16);
#pragma unroll
        for (int ks = 0; ks < 8; ++ks) kf[1][ks] = *(const bf16x8*)(kb + (size_t)32 * 128 + ks * 16);
        f32x16 acc[4];
#pragma unroll
        for (int nt = 0; nt < 4; ++nt) {
            if (nt + 2 < 4) {
#pragma unroll
                for (int ks = 0; ks < 8; ++ks) kf[(nt + 2) % 3][ks] = *(const bf16x8*)(kb + (size_t)(nt + 2) * 32 * 128 + ks * 16);
            }
            __builtin_amdgcn_sched_barrier(0);
            acc[nt] = (f32x16){0.f, 0.f, 0.f, 0.f, 0.f, 0.f, 0.f, 0.f, 0.f, 0.f, 0.f, 0.f, 0.f, 0.f, 0.f, 0.f};
#pragma unroll
            for (int ks = 0; ks < 8; ++ks) acc[nt] = __builtin_amdgcn_mfma_f32_32x32x16_bf16(kf[nt % 3][ks], qf[ks], acc[nt], 0, 0, 0);
            __builtin_amdgcn_sched_barrier(0);
        }
        float v[64];
#pragma unroll
        for (int nt = 0; nt < 4; ++nt)
#pragma unroll
            for (int r = 0; r < 16; ++r) { const unsigned n = (unsigned)(nt * 32 + (r & 3) + 8 * (r >> 2)); v[nt * 16 + r] = __uint_as_float((__float_as_uint(acc[nt][r]) & 0xFFFFFF80u) | n); }
        float top[16];
        top16_of_64(v, top);
        float oth[16];
#pragma unroll
        for (int i = 0; i < 16; ++i) { top[i] = __uint_as_float(__float_as_uint(top[i]) | (unsigned)(half << 2)); oth[i] = __shfl_xor(top[i], 32); }
        merge16_desc(top, oth);
        if (half == 0) {
#pragma unroll
            for (int i = 0; i < 16; ++i) RES[((hl * 2 + c) * 16 + i) * 32 + t] = top[i];
        }
    }
    __builtin_amdgcn_s_waitcnt(0xC07F);
    {
        float a[16], b[16];
#pragma unroll
        for (int i = 0; i < 16; ++i) { a[i] = RES[((half * 2 + 0) * 16 + i) * 32 + t]; b[i] = RES[((half * 2 + 1) * 16 + i) * 32 + t]; }
        constexpr CandTab CT = make_cand();
        float v[64];
#pragma unroll
        for (int n = 0; n < 64; ++n) {
            if (CT.i[n] >= 0) v[n] = __uint_as_float((__float_as_uint(a[CT.i[n] < 0 ? 0 : CT.i[n]] + b[CT.j[n] < 0 ? 0 : CT.j[n]]) & 0xFFFFFF00u) | (unsigned)(CT.i[n] * 16 + CT.j[n]));
            else v[n] = __uint_as_float(0xFF800000u);
        }
        float top[16];
        top16_of_64(v, top);
        float e[16], sum = 0.f;
#pragma unroll
        for (int i = 0; i < 16; ++i) { e[i] = __expf(top[i] - top[0]); sum += e[i]; }
        const float inv = 1.0f / sum;
        const int head = 2 * wid + half;
#pragma unroll
        for (int i = 0; i < 16; ++i) {
            const unsigned code = __float_as_uint(top[i]) & 0xFFu;
            const unsigned ia = __float_as_uint(RES[((half * 2 + 0) * 16 + (code >> 4)) * 32 + t]) & 0x7Fu;
            const unsigned ib = __float_as_uint(RES[((half * 2 + 1) * 16 + (code & 15u)) * 32 + t]) & 0x7Fu;
            IDS[t * 128 + head * 16 + i] = (unsigned short)(ia * 128u + ib);
            GATE[t * 128 + head * 16 + i] = e[i] * inv;
        }
    }
    half_sync();
#pragma unroll
    for (int it = 0; it < 16; ++it) {
        const int item = it * 256 + tid, tl = item >> 7, j = item & 127, k = 8 * (j & 15) + (j >> 4);
        WS(unsigned short, OFF_IDSP)[(size_t)(tok0 + tl) * 128 + j] = IDS[tl * 128 + k];
        WS(float, OFF_GATEP)[(size_t)(tok0 + tl) * 128 + j] = GATE[tl * 128 + k];
    }
    {
        u32x4 hA[8], hB[8];
#pragma unroll
        for (int ti = 0; ti < 8; ++ti) { const bf16* yrow = WS(bf16, OFF_Y1B) + ((size_t)tok0 + wid * 8 + ti) * 1024 + lane * 16; hA[ti] = *(const u32x4*)yrow; hB[ti] = *(const u32x4*)(yrow + 8); }
        float gg[16], bb[16];
#pragma unroll
        for (int q4 = 0; q4 < 4; ++q4) { const f32x4 gv = *(const f32x4*)(p.ln1_g + lane * 16 + 4 * q4), bv = *(const f32x4*)(p.ln1_b + lane * 16 + 4 * q4);
#pragma unroll
            for (int e = 0; e < 4; ++e) { gg[4 * q4 + e] = gv[e]; bb[4 * q4 + e] = bv[e]; } }
#pragma unroll
        for (int ti = 0; ti < 8; ++ti) {
            const size_t tok = (size_t)tok0 + wid * 8 + ti;
            const f32x2 st = *(const f32x2*)(WS(float, OFF_STAT1) + tok * 2);
            const float mu = st.x * (1.0f / 1024.0f), rs = rsqrtf(fmaxf(st.y * (1.0f / 1024.0f) - mu * mu, 0.f) + 1e-5f);
            float hf[16];
#pragma unroll
            for (int k = 0; k < 4; ++k) { hf[2 * k] = __uint_as_float(hA[ti][k] << 16); hf[2 * k + 1] = __uint_as_float(hA[ti][k] & 0xFFFF0000u); hf[8 + 2 * k] = __uint_as_float(hB[ti][k] << 16); hf[9 + 2 * k] = __uint_as_float(hB[ti][k] & 0xFFFF0000u); }
#pragma unroll
            for (int k = 0; k < 16; ++k) hf[k] = (hf[k] - mu) * rs * gg[k] + bb[k];
            u32x4 o0, o1;
#pragma unroll
            for (int k = 0; k < 4; ++k) { o0[k] = pack_bf2(hf[2 * k], hf[2 * k + 1]); o1[k] = pack_bf2(hf[8 + 2 * k], hf[9 + 2 * k]); }
            bf16* hrow = WS(bf16, OFF_R1) + tok * 1024 + lane * 16;
            *(u32x4*)hrow = o0; *(u32x4*)(hrow + 8) = o1;
            float am = 0.f;
#pragma unroll
            for (int k = 0; k < 16; ++k) am = fmaxf(am, fabsf(hf[k]));
            am = wave_max(am);
            const float hinv = am > 0.f ? 127.0f / am : 0.f;
            u32x4 hq;
#pragma unroll
            for (int i = 0; i < 4; ++i) { unsigned a4 = 0u;
#pragma unroll
                for (int e = 0; e < 4; ++e) a4 |= ((unsigned)(int)rintf(hf[4 * i + e] * hinv) & 0xFFu) << (8 * e);
                hq[i] = a4; }
            *(u32x4*)(p.ws + OFF_HQ + tok * 1024 + lane * 16) = hq;
            if (lane == 0) WS(float, OFF_HSC)[tok] = am * (1.0f / 127.0f);
            if (lane < 2) WS(float, OFF_STAT)[tok * 2 + lane] = 0.f;
        }
    }
    half_sync();
}

template <class F>
__device__ __forceinline__ void sliced_units(unsigned* q  , unsigned xcc, volatile unsigned* slot, F f) {
    for (unsigned off = 0; off < 8u; ++off) {
        const unsigned s = (xcc + off) & 7u;
        for (;;) {
            const unsigned t = queue_next(q + 64 * s, slot);
            if (t >= (unsigned)(NT / 32)) break;
            f(t, s);
        }
    }
}
__device__ __forceinline__ void peer_u_unit(const P& p, unsigned tile, unsigned s, unsigned char* lds) {
    const int tid = tidx(), wid = tid >> 6, lane = tid & 63, g = lane >> 3, cg = lane & 7;
    const unsigned char* ub = p.ws + OFF_UQ + s * 128 + cg * 16;
    const size_t tokw = (size_t)tile * 32 + wid * 8;
    const unsigned short* idp = WS(unsigned short, OFF_IDSP) + tokw * 128 + g * 16;
    const unsigned char* hqp = p.ws + OFF_HQ + tokw * 1024 + s * 128 + cg * 16;
    u32x4 idv[2][2], hq[2], rows[2][16];
    idv[0][0] = *(const u32x4*)idp; idv[0][1] = *(const u32x4*)(idp + 8);
    idv[1][0] = *(const u32x4*)(idp + 128); idv[1][1] = *(const u32x4*)(idp + 136);
#define PEER_ISSUE_ROWS(BUF, TI, BASE)                                                                                   \
    { _Pragma("unroll") for (int i = 0; i < 16; ++i) {                                                                   \
          const unsigned w_ = i < 8 ? idv[BUF][0][i >> 1] : idv[BUF][1][(i - 8) >> 1];                                    \
          const unsigned id_ = (i & 1) ? (w_ >> 16) : (w_ & 0xFFFFu);                                                    \
          rows[BUF][i] = *(const u32x4*)((BASE) + (size_t)id_ * 1024); } }
    PEER_ISSUE_ROWS(0, 0, ub)
    hq[0] = *(const u32x4*)hqp;
#pragma unroll
    for (int ti = 0; ti < 8; ++ti) {
        const int cur = ti & 1, nxt = cur ^ 1;
        if (ti + 1 < 8) { PEER_ISSUE_ROWS(nxt, ti + 1, ub) hq[nxt] = *(const u32x4*)(hqp + (size_t)(ti + 1) * 1024); }
        if (ti + 2 < 8) { idv[cur][0] = *(const u32x4*)(idp + (ti + 2) * 128); idv[cur][1] = *(const u32x4*)(idp + (ti + 2) * 128 + 8); }
        int pd[16];
#pragma unroll
        for (int i = 0; i < 16; ++i) {
            const u32x4 uq = rows[cur][i];
            int sm = __builtin_amdgcn_sdot4((int)uq.x, (int)hq[cur].x, 0, false);
            sm = __builtin_amdgcn_sdot4((int)uq.y, (int)hq[cur].y, sm, false); sm = __builtin_amdgcn_sdot4((int)uq.z, (int)hq[cur].z, sm, false); sm = __builtin_amdgcn_sdot4((int)uq.w, (int)hq[cur].w, sm, false);
            pd[i] = sm;
        }
#pragma unroll
        for (int r = 0; r < 8; ++r) { const bool up = (lane & 4) != 0; const int keep = up ? pd[r + 8] : pd[r], send = up ? pd[r] : pd[r + 8]; pd[r] = keep + __shfl_xor(send, 4); }
#pragma unroll
        for (int r = 0; r < 4; ++r) { const bool up = (lane & 2) != 0; const int keep = up ? pd[r + 4] : pd[r], send = up ? pd[r] : pd[r + 4]; pd[r] = keep + __shfl_xor(send, 2); }
#pragma unroll
        for (int r = 0; r < 2; ++r) { const bool up = (lane & 1) != 0; const int keep = up ? pd[r + 2] : pd[r], send = up ? pd[r] : pd[r + 2]; pd[r] = keep + __shfl_xor(send, 1); }
        const unsigned o = ((unsigned)((pd[0] + 32) >> 6) & 0xFFFFu) | ((unsigned)((pd[1] + 32) >> 6) << 16);
        *(unsigned*)(p.ws + OFF_PD + (((size_t)s * NT + tokw + ti) * 128 + 2 * lane) * 2) = o;
    }
    (void)lds;
}
__device__ __forceinline__ void ph_peer_coef(const P& p) {
    const int tid = tidx(), wid = tid >> 6, lane = tid & 63;
    for (unsigned tb = (VBID * 4 + wid) * 4; tb < (unsigned)NT; tb += VGRID * 16) {
        int s0[4], s1[4]; unsigned idw[4]; f32x2 gt[4]; float hs[4];
#pragma unroll
        for (int q = 0; q < 4; ++q) {
            const unsigned tok = tb + q;
            s0[q] = 0; s1[q] = 0;
#pragma unroll
            for (int s = 0; s < 8; ++s) { const unsigned v = *(const unsigned*)(p.ws + OFF_PD + (((size_t)s * NT + tok) * 128 + 2 * lane) * 2); s0[q] += (int)(short)(v & 0xFFFFu); s1[q] += (int)(short)(v >> 16); }
            idw[q] = *(const unsigned*)(WS(unsigned short, OFF_IDSP) + (size_t)tok * 128 + 2 * lane);
            gt[q] = *(const f32x2*)(WS(float, OFF_GATEP) + (size_t)tok * 128 + 2 * lane);
            hs[q] = WS(float, OFF_HSC)[tok];
        }
        float su0[4], su1[4], sv0[4], sv1[4];
#pragma unroll
        for (int q = 0; q < 4; ++q) { const unsigned id0 = idw[q] & 0xFFFFu, id1 = idw[q] >> 16; su0[q] = WS(float, OFF_SU)[id0]; su1[q] = WS(float, OFF_SU)[id1]; sv0[q] = WS(float, OFF_SV)[id0]; sv1[q] = WS(float, OFF_SV)[id1]; }
#pragma unroll
        for (int q = 0; q < 4; ++q) {
            const unsigned tok = tb + q;
            const float c0 = gelu_erf((float)(s0[q] << 6) * hs[q] * su0[q]) * gt[q].x * sv0[q];
            const float c1 = gelu_erf((float)(s1[q] << 6) * hs[q] * su1[q]) * gt[q].y * sv1[q];
            const float am = wave_max(fmaxf(fabsf(c0), fabsf(c1)));
            const float inv = am > 0.f ? 127.0f / am : 0.f;
            const unsigned q0 = (unsigned)(int)rintf(c0 * inv) & 0xFFu, q1 = (unsigned)(int)rintf(c1 * inv) & 0xFFu;
            *(unsigned short*)(p.ws + OFF_COEF + (size_t)tok * 128 + 2 * lane) = (unsigned short)(q0 | (q1 << 8));
            if (lane == 0) WS(float, OFF_CSC)[tok] = am * (1.0f / 127.0f);
        }
    }
}
__device__ __forceinline__ void peer_v_unit(const P& p, unsigned tile, unsigned s, unsigned char* lds) {
    const int tid = tidx(), wid = tid >> 6, lane = tid & 63, g = lane >> 3, cg = lane & 7;
    const unsigned char* vb = p.ws + OFF_VQ + s * 128 + cg * 16;
    const size_t tokw = (size_t)tile * 32 + wid * 8;
    const unsigned short* idp = WS(unsigned short, OFF_IDSP) + tokw * 128 + g * 16;
    const unsigned char* cqp = p.ws + OFF_COEF + tokw * 128 + g * 16;
    u32x4 idv[2][2], rows[2][16], cq[2];
    idv[0][0] = *(const u32x4*)idp; idv[0][1] = *(const u32x4*)(idp + 8);
    idv[1][0] = *(const u32x4*)(idp + 128); idv[1][1] = *(const u32x4*)(idp + 136);
    PEER_ISSUE_ROWS(0, 0, vb)
    cq[0] = *(const u32x4*)cqp;
#pragma unroll
    for (int ti = 0; ti < 8; ++ti) {
        const int cur = ti & 1, nxt = cur ^ 1;
        const size_t tok = tokw + ti;
        if (ti + 1 < 8) { PEER_ISSUE_ROWS(nxt, ti + 1, vb) cq[nxt] = *(const u32x4*)(cqp + (ti + 1) * 128); }
        if (ti + 2 < 8) { idv[cur][0] = *(const u32x4*)(idp + (ti + 2) * 128); idv[cur][1] = *(const u32x4*)(idp + (ti + 2) * 128 + 8); }
        int acc[16];
#pragma unroll
        for (int e = 0; e < 16; ++e) acc[e] = 0;
#pragma unroll
        for (int q = 0; q < 4; ++q) {
            const int cw = (int)cq[cur][q];
#pragma unroll
            for (int d = 0; d < 4; ++d) {
                const unsigned a = rows[cur][4 * q][d], bq = rows[cur][4 * q + 1][d], c = rows[cur][4 * q + 2][d], dd = rows[cur][4 * q + 3][d];
                const unsigned x0 = __builtin_amdgcn_perm(bq, a, 0x05010400u), x1 = __builtin_amdgcn_perm(bq, a, 0x07030602u);
                const unsigned y0 = __builtin_amdgcn_perm(dd, c, 0x05010400u), y1 = __builtin_amdgcn_perm(dd, c, 0x07030602u);
                const unsigned t0 = __builtin_amdgcn_perm(y0, x0, 0x05040100u), t1 = __builtin_amdgcn_perm(y0, x0, 0x07060302u);
                const unsigned t2 = __builtin_amdgcn_perm(y1, x1, 0x05040100u), t3 = __builtin_amdgcn_perm(y1, x1, 0x07060302u);
                acc[4 * d] = __builtin_amdgcn_sdot4((int)t0, cw, acc[4 * d], false); acc[4 * d + 1] = __builtin_amdgcn_sdot4((int)t1, cw, acc[4 * d + 1], false);
                acc[4 * d + 2] = __builtin_amdgcn_sdot4((int)t2, cw, acc[4 * d + 2], false); acc[4 * d + 3] = __builtin_amdgcn_sdot4((int)t3, cw, acc[4 * d + 3], false);
            }
        }
#pragma unroll
        for (int r = 0; r < 8; ++r) { const bool up = (lane & 32) != 0; const int keep = up ? acc[r + 8] : acc[r], send = up ? acc[r] : acc[r + 8]; acc[r] = keep + __shfl_xor(send, 32); }
#pragma unroll
        for (int r = 0; r < 4; ++r) { const bool up = (lane & 16) != 0; const int keep = up ? acc[r + 4] : acc[r], send = up ? acc[r] : acc[r + 4]; acc[r] = keep + __shfl_xor(send, 16); }
#pragma unroll
        for (int r = 0; r < 2; ++r) { const bool up = (lane & 8) != 0; const int keep = up ? acc[r + 2] : acc[r], send = up ? acc[r] : acc[r + 2]; acc[r] = keep + __shfl_xor(send, 8); }
        const float csc = WS(float, OFF_CSC)[tok];
        const int col = (int)s * 128 + cg * 16 + 2 * g;
        const unsigned hw = *(const unsigned*)(WS(bf16, OFF_R1) + tok * 1024 + col);
        const float y0 = ALPHA * __uint_as_float(hw << 16) + csc * (float)acc[0], y1 = ALPHA * __uint_as_float(hw & 0xFFFF0000u) + csc * (float)acc[1];
        *(unsigned*)(WS(bf16, OFF_Y2B) + tok * 1024 + col) = pack_bf2(y0, y1);
        const float s1 = wave_sum(y0 + y1), s2 = wave_sum(y0 * y0 + y1 * y1);
        if (lane == 0) { atomicAdd(WS(float, OFF_STAT) + tok * 2, s1); atomicAdd(WS(float, OFF_STAT) + tok * 2 + 1, s2); }
    }
    (void)lds;
}
__device__ __forceinline__ void ph_ln2(const P& p) {
    const int tid = tidx(), wid = tid >> 6, lane = tid & 63;
    f32x4 gg[4], bb[4];
#pragma unroll
    for (int i = 0; i < 4; ++i) { gg[i] = *(const f32x4*)(p.ln2_g + i * 256 + lane * 4); bb[i] = *(const f32x4*)(p.ln2_b + i * 256 + lane * 4); }
    for (unsigned tb = (VBID * 4 + wid) * 4; tb < (unsigned)NT; tb += VGRID * 16) {
        f32x2 st[4]; u32x2 yr[4][4];
#pragma unroll
        for (int q = 0; q < 4; ++q) { st[q] = *(const f32x2*)(WS(float, OFF_STAT) + (size_t)(tb + q) * 2);
#pragma unroll
            for (int i = 0; i < 4; ++i) yr[q][i] = *(const u32x2*)(WS(bf16, OFF_Y2B) + (size_t)(tb + q) * 1024 + i * 256 + lane * 4); }
#pragma unroll
        for (int q = 0; q < 4; ++q) {
            const float mu = st[q].x * (1.0f / 1024.0f), rs = rsqrtf(fmaxf(st[q].y * (1.0f / 1024.0f) - mu * mu, 0.f) + 1e-5f);
            float* orow = p.out + (size_t)(tb + q) * 1024;
#pragma unroll
            for (int i = 0; i < 4; ++i) {
                const f32x4 y = (f32x4){__uint_as_float(yr[q][i].x << 16), __uint_as_float(yr[q][i].x & 0xFFFF0000u), __uint_as_float(yr[q][i].y << 16), __uint_as_float(yr[q][i].y & 0xFFFF0000u)};
                *(f32x4*)(orow + i * 256 + lane * 4) = (y - mu) * rs * gg[i] + bb[i];
            }
        }
    }
}

__device__ __forceinline__ void conv_tile(const P& p, int b, int c, int ch0, unsigned char* T, bf16* nat, int nat_ld, int nat_col0) {
    const int tid = tidx(), cg = tid & 15, lb = tid >> 4, ch = ch0 + cg * 8;
    float w[4][8], bias[8];
#pragma unroll
    for (int j = 0; j < 4; ++j) { const f32x4 a = *(const f32x4*)(p.conv_w + j * 1024 + ch), bq = *(const f32x4*)(p.conv_w + j * 1024 + ch + 4);
#pragma unroll
        for (int e = 0; e < 4; ++e) { w[j][e] = a[e]; w[j][4 + e] = bq[e]; } }
    { const f32x4 a = *(const f32x4*)(p.conv_b + ch), bq = *(const f32x4*)(p.conv_b + ch + 4);
#pragma unroll
      for (int e = 0; e < 4; ++e) { bias[e] = a[e]; bias[4 + e] = bq[e]; } }
    const bf16* base = WS(bf16, OFF_XBC) + (size_t)b * SEQ * 1024 + ch;
#pragma unroll 1
    for (int hb = 0; hb < 2; ++hb) {
        const int s0 = c * 128 + lb * 8 + hb * 4;
        float R[4][8];
#pragma unroll
        for (int i = 0; i < 7; ++i) {
            const int sp = s0 - 3 + i;
            u32x4 raw = (u32x4){0u, 0u, 0u, 0u};
            if (sp >= 0) raw = *(const u32x4*)(base + (size_t)sp * 1024);
#pragma unroll
            for (int e = 0; e < 4; ++e) { R[i & 3][2 * e] = __uint_as_float(raw[e] << 16); R[i & 3][2 * e + 1] = __uint_as_float(raw[e] & 0xFFFF0000u); }
            if (i >= 3) {
                const int l = lb * 8 + hb * 4 + (i - 3);
                float v[8];
#pragma unroll
                for (int e = 0; e < 8; ++e) { v[e] = bias[e] + w[0][e] * R[(i - 3) & 3][e] + w[1][e] * R[(i - 2) & 3][e] + w[2][e] * R[(i - 1) & 3][e] + w[3][e] * R[i & 3][e]; v[e] = silu_f(v[e]); }
                u32x4 o; o.x = pack_bf2(v[0], v[1]); o.y = pack_bf2(v[2], v[3]); o.z = pack_bf2(v[4], v[5]); o.w = pack_bf2(v[6], v[7]);
                *(u32x4*)(T + l * 256 + ((cg ^ (l & 15)) * 16)) = o;
                if (nat) *(u32x4*)(nat + ((size_t)b * SEQ + c * 128 + l) * nat_ld + nat_col0 + cg * 8) = o;
            }
        }
    }
}
__device__ __forceinline__ void tile_transposed_store(const unsigned char* T, bf16* dst) {
    const int tid = tidx(), lg = tid & 15, cb = tid >> 4;
#pragma unroll
    for (int it = 0; it < 8; ++it) {
        const int ch = cb + 16 * it;
        unsigned e[8];
#pragma unroll
        for (int i = 0; i < 8; ++i) { const int l = lg * 8 + i; e[i] = *(const unsigned short*)(T + l * 256 + (((ch >> 3) ^ (l & 15)) * 16) + (ch & 7) * 2); }
        u32x4 o; o.x = e[0] | (e[1] << 16); o.y = e[2] | (e[3] << 16); o.z = e[4] | (e[5] << 16); o.w = e[6] | (e[7] << 16);
        *(u32x4*)(dst + (size_t)ch * SEQ + lg * 8) = o;
    }
}
__device__ __forceinline__ void conv_unit(const P& p, unsigned u, unsigned char* lds) {
    unsigned char* T0 = lds; unsigned char* T1 = lds + 32768;
    if (u < 1024u) {
        const int hp = (int)(u & 3u), c = (int)((u >> 2) & 15u), b = (int)(u >> 6);
        conv_tile(p, b, c, hp * 128, T0, nullptr, 0, 0);
        half_sync();
        tile_transposed_store(T0, WS(bf16, OFF_XT) + ((size_t)b * 512 + hp * 128) * SEQ + c * 128);
        half_sync();
    } else {
        const unsigned v = u - 1024u; const int g = (int)(v & 1u), c = (int)((v >> 1) & 15u), b = (int)(v >> 5);
        conv_tile(p, b, c, 512 + g * 128, T0, nullptr, 0, 0);
        conv_tile(p, b, c, 768 + g * 128, T1, WS(bf16, OFF_CN), 256, g * 128);
        half_sync();
        tile_transposed_store(T0, WS(bf16, OFF_BT) + ((size_t)(b * 2 + g) * 128) * SEQ + c * 128);
        const int wid = tidx() >> 6, lane = tidx() & 63, fr = lane & 15, fq = lane >> 4;
        f32x4 acc[8][2];
#pragma unroll
        for (int nt = 0; nt < 8; ++nt) { acc[nt][0] = (f32x4){0.f, 0.f, 0.f, 0.f}; acc[nt][1] = (f32x4){0.f, 0.f, 0.f, 0.f}; }
#pragma unroll
        for (int ks = 0; ks < 4; ++ks) {
            bf16x8 cf[2];
#pragma unroll
            for (int lt = 0; lt < 2; ++lt) cf[lt] = *(const bf16x8*)(T1 + (wid * 32 + lt * 16 + fr) * 256 + (((ks * 4 + fq) ^ fr) * 16));
#pragma unroll
            for (int nt = 0; nt < 8; ++nt) if (nt < 2 * wid + 2) {
                const bf16x8 bfg = *(const bf16x8*)(T0 + (nt * 16 + fr) * 256 + (((ks * 4 + fq) ^ fr) * 16));
                acc[nt][0] = __builtin_amdgcn_mfma_f32_16x16x32_bf16(bfg, cf[0], acc[nt][0], 0, 0, 0);
                acc[nt][1] = __builtin_amdgcn_mfma_f32_16x16x32_bf16(bfg, cf[1], acc[nt][1], 0, 0, 0);
            }
        }
        bf16* cbp = WS(bf16, OFF_CB) + ((size_t)((b * 16 + c) * 2 + g)) * 16384;
#pragma unroll
        for (int nt = 0; nt < 8; ++nt) if (nt < 2 * wid + 2)
#pragma unroll
            for (int lt = 0; lt < 2; ++lt) { u32x2 o; o.x = pack_bf2(acc[nt][lt][0], acc[nt][lt][1]); o.y = pack_bf2(acc[nt][lt][2], acc[nt][lt][3]); *(u32x2*)(cbp + (wid * 32 + lt * 16 + fr) * 128 + nt * 16 + 4 * fq) = o; }
        half_sync();
    }
}
__device__ __forceinline__ void scanw_unit(const P& p, unsigned u) {
    const int tid = tidx(), wid = tid >> 6, lane = tid & 63;
    const int c = (int)(u & 15u), b = (int)(u >> 4);
    const size_t tokb = (size_t)b * SEQ + c * 128;
#pragma unroll
    for (int hh = 0; hh < 2; ++hh) {
        const int h = wid * 2 + hh;
        const float A = -__expf(p.a_log[h]);
        const float dt0 = WS(float, OFF_DT)[(tokb + lane) * 8 + h], dt1 = WS(float, OFF_DT)[(tokb + 64 + lane) * 8 + h];
        const float s0 = wave_incl_scan(dt0 * A, lane);
        const float t0 = __shfl(s0, 63);
        const float s1 = wave_incl_scan(dt1 * A, lane) + t0;
        const float total = __shfl(s1, 63);
        float* wl = WS(float, OFF_WL) + (size_t)(b * 8 + h) * SEQ + c * 128;
        wl[lane] = dt0 * __expf(total - s0); wl[64 + lane] = dt1 * __expf(total - s1);
        if (lane == 0) WS(float, OFF_TOT)[(b * 8 + h) * 16 + c] = total;
    }
}
__device__ __forceinline__ void ph_conv(const P& p, unsigned char* lds) {
    for (unsigned u = VBID; u < 1536u + 256u; u += VGRID) { if (u < 1536u) conv_unit(p, u, lds); else scanw_unit(p, u - 1536u); }
}

template <int LD = SEQ>
__device__ __forceinline__ void ssd_stage(const bf16* xt  , int c, unsigned char* st, int wid, int lane) {
#pragma unroll
    for (int i = 0; i < 4; ++i) {
        const int piece = wid * 4 + i, row = piece * 4 + (lane >> 4), chk = (lane & 15) ^ (row & 15);
        __builtin_amdgcn_global_load_lds((const u32*)(xt + (size_t)row * LD + c * 128 + chk * 8), (u32*)(st + piece * 1024 + lane * 16), 16, 0, 0);
    }
}
__device__ __forceinline__ void ssd_state_unit(const P& p, unsigned u, unsigned char* lds) {
    const int tid = tidx();
    const int b = (int)(u >> 3), h = (int)(u & 7u), g = h >> 2;
    const bf16* xt = WS(bf16, OFF_XT) + (size_t)(b * 8 + h) * 64 * SEQ;
    unsigned char* XTB = lds;
    f32x4 st[2][4];
#pragma unroll
    for (int nt = 0; nt < 2; ++nt)
#pragma unroll
        for (int pt = 0; pt < 4; ++pt) st[nt][pt] = (f32x4){0.f, 0.f, 0.f, 0.f};
    ssd_stage(xt, 0, XTB, tid >> 6, tid & 63);
    ssd_stage(xt, 1, XTB + 16384, tid >> 6, tid & 63);
    bf16x8 bfg[4][2]; f32x4 wv[4][2]; float total;
    {
        const int wid = tid >> 6, lane = tid & 63, fr = lane & 15, fq = lane >> 4;
        const bf16* btp = WS(bf16, OFF_BT) + ((size_t)(b * 2 + g) * 128 + wid * 32 + fr) * SEQ + 8 * fq;
        const float* wlp = WS(float, OFF_WL) + (size_t)(b * 8 + h) * SEQ + 8 * fq;
#pragma unroll
        for (int ks = 0; ks < 4; ++ks) { bfg[ks][0] = *(const bf16x8*)(btp + ks * 32); bfg[ks][1] = *(const bf16x8*)(btp + (size_t)16 * SEQ + ks * 32); wv[ks][0] = *(const f32x4*)(wlp + ks * 32); wv[ks][1] = *(const f32x4*)(wlp + ks * 32 + 4); }
        total = WS(float, OFF_TOT)[(b * 8 + h) * 16];
    }
    for (int c = 0; c < 15; ++c) {
        int tid_c = tid; asm volatile("" : "+v"(tid_c));
        const int wid = tid_c >> 6, lane = tid_c & 63, fr = lane & 15, fq = lane >> 4;
        bf16x8 bw[4][2];
#pragma unroll
        for (int ks = 0; ks < 4; ++ks)
#pragma unroll
            for (int nt = 0; nt < 2; ++nt) {
                const u32x4 raw = __builtin_bit_cast(u32x4, bfg[ks][nt]);
                float m[8];
#pragma unroll
                for (int e = 0; e < 4; ++e) { m[2 * e] = __uint_as_float(raw[e] << 16); m[2 * e + 1] = __uint_as_float(raw[e] & 0xFFFF0000u); }
#pragma unroll
                for (int e = 0; e < 8; ++e) m[e] *= (e < 4 ? wv[ks][0][e & 3] : wv[ks][1][e & 3]);
                u32x4 pk; pk.x = pack_bf2(m[0], m[1]); pk.y = pack_bf2(m[2], m[3]); pk.z = pack_bf2(m[4], m[5]); pk.w = pack_bf2(m[6], m[7]);
                bw[ks][nt] = __builtin_bit_cast(bf16x8, pk);
            }
        const float cd = __expf(total);
        asm volatile("s_waitcnt vmcnt(12)" ::: "memory");
        half_sync();
        if (c + 1 < 15) {
            const bf16* btp = WS(bf16, OFF_BT) + ((size_t)(b * 2 + g) * 128 + wid * 32 + fr) * SEQ + (c + 1) * 128 + 8 * fq;
            const float* wlp = WS(float, OFF_WL) + (size_t)(b * 8 + h) * SEQ + (c + 1) * 128 + 8 * fq;
#pragma unroll
            for (int ks = 0; ks < 4; ++ks) { bfg[ks][0] = *(const bf16x8*)(btp + ks * 32); bfg[ks][1] = *(const bf16x8*)(btp + (size_t)16 * SEQ + ks * 32); wv[ks][0] = *(const f32x4*)(wlp + ks * 32); wv[ks][1] = *(const f32x4*)(wlp + ks * 32 + 4); }
            total = WS(float, OFF_TOT)[(b * 8 + h) * 16 + c + 1];
        }
        if (c + 2 < 15) ssd_stage(xt, c + 2, XTB + ((c + 2) % 3) * 16384, wid, lane);
        const unsigned char* X = XTB + (c % 3) * 16384;
#pragma unroll
        for (int nt = 0; nt < 2; ++nt)
#pragma unroll
            for (int pt = 0; pt < 4; ++pt) st[nt][pt] *= cd;
#pragma unroll
        for (int ks = 0; ks < 4; ++ks)
#pragma unroll
            for (int pt = 0; pt < 4; ++pt) {
                const bf16x8 xf = *(const bf16x8*)(X + (pt * 16 + fr) * 256 + (((ks * 4 + fq) ^ fr) * 16));
                st[0][pt] = __builtin_amdgcn_mfma_f32_16x16x32_bf16(bw[ks][0], xf, st[0][pt], 0, 0, 0);
                st[1][pt] = __builtin_amdgcn_mfma_f32_16x16x32_bf16(bw[ks][1], xf, st[1][pt], 0, 0, 0);
            }
        bf16* pvo = WS(bf16, OFF_PREV) + ((size_t)((b * 8 + h) * 16 + c + 1)) * 8192;
#pragma unroll
        for (int nt = 0; nt < 2; ++nt)
#pragma unroll
            for (int pt = 0; pt < 4; ++pt) {
                u32x2 o; o.x = pack_bf2(st[nt][pt][0], st[nt][pt][1]); o.y = pack_bf2(st[nt][pt][2], st[nt][pt][3]);
                *(u32x2*)(pvo + (pt * 16 + fr) * 128 + wid * 32 + nt * 16 + 4 * fq) = o;
            }
    }
    asm volatile("s_waitcnt vmcnt(0)" ::: "memory");
    half_sync();
    if (tid == 0) {
        __builtin_amdgcn_fence(__ATOMIC_RELEASE, "agent");
        asm volatile("s_waitcnt vmcnt(0)" ::: "memory");
        __hip_atomic_fetch_add((unsigned*)(p.ws + OFF_CTRL + 14336 + 1024), 1u, __ATOMIC_RELAXED, __HIP_MEMORY_SCOPE_AGENT);
    }
    half_sync();
}
__device__ __forceinline__ void ssd_out_unit(const P& p, unsigned u, unsigned char* lds) {
    const int tid = tidx(), wid = tid >> 6, lane = tid & 63, fr = lane & 15, fq = lane >> 4;
    const int h = (int)(u & 7u), c = (int)((u >> 3) & 15u), b = (int)(u >> 7), g = h >> 2;
    const float A = -__expf(p.a_log[h]), Dh = p.d_skip[h];
    unsigned char* X = lds; unsigned char* PV = lds + 16384; float* par_acs = (float*)(lds + 32768); float* par_dt = par_acs + 128;
    const size_t tokb = (size_t)b * SEQ + c * 128;
    const int lrow0 = wid * 32 + fr;
    ssd_stage(WS(bf16, OFF_XT) + (size_t)(b * 8 + h) * 64 * SEQ, c, X, wid, lane);
    if (c > 0) ssd_stage<128>(WS(bf16, OFF_PREV) + ((size_t)((b * 8 + h) * 16 + c)) * 8192, 0, PV, wid, lane);
    bf16x8 cf[4][2];
    if (c > 0) {
#pragma unroll
        for (int ks = 0; ks < 4; ++ks)
#pragma unroll
            for (int lt = 0; lt < 2; ++lt) cf[ks][lt] = *(const bf16x8*)(WS(bf16, OFF_CN) + (tokb + lrow0 + 16 * lt) * 256 + g * 128 + ks * 32 + 8 * fq);
    }
    const bf16* cbp = WS(bf16, OFF_CB) + ((size_t)((b * 16 + c) * 2 + g)) * 16384;
    u32x4 cbr[4][2];
#pragma unroll
    for (int ks = 0; ks < 4; ++ks) if (ks <= wid)
#pragma unroll
        for (int lt = 0; lt < 2; ++lt) cbr[ks][lt] = *(const u32x4*)(cbp + (lrow0 + 16 * lt) * 128 + ks * 32 + 8 * fq);
    u32x2 zr[2][4];
#pragma unroll
    for (int lt = 0; lt < 2; ++lt)
#pragma unroll
        for (int pt = 0; pt < 4; ++pt) zr[lt][pt] = *(const u32x2*)(WS(bf16, OFF_Z) + (tokb + lrow0 + 16 * lt) * 512 + h * 64 + pt * 16 + 4 * fq);
    {
        const float dt0 = WS(float, OFF_DT)[(tokb + lane) * 8 + h], dt1 = WS(float, OFF_DT)[(tokb + 64 + lane) * 8 + h];
        const float s0 = wave_incl_scan(dt0 * A, lane);
        const float t0 = __shfl(s0, 63);
        const float s1 = wave_incl_scan(dt1 * A, lane) + t0;
        if (wid == 0) { par_acs[lane] = s0; par_acs[64 + lane] = s1; par_dt[lane] = dt0; par_dt[64 + lane] = dt1; }
    }
    asm volatile("s_waitcnt vmcnt(0)" ::: "memory");
    half_sync();
    f32x4 y[4][2];
#pragma unroll
    for (int pt = 0; pt < 4; ++pt) { y[pt][0] = (f32x4){0.f, 0.f, 0.f, 0.f}; y[pt][1] = (f32x4){0.f, 0.f, 0.f, 0.f}; }
    float acsl[2];
#pragma unroll
    for (int lt = 0; lt < 2; ++lt) acsl[lt] = par_acs[lrow0 + 16 * lt];
    if (c > 0) {
#pragma unroll
        for (int ks = 0; ks < 4; ++ks)
#pragma unroll
            for (int pt = 0; pt < 4; ++pt) {
                const bf16x8 pf = *(const bf16x8*)(PV + (pt * 16 + fr) * 256 + (((ks * 4 + fq) ^ fr) * 16));
                y[pt][0] = __builtin_amdgcn_mfma_f32_16x16x32_bf16(pf, cf[ks][0], y[pt][0], 0, 0, 0);
                y[pt][1] = __builtin_amdgcn_mfma_f32_16x16x32_bf16(pf, cf[ks][1], y[pt][1], 0, 0, 0);
            }
#pragma unroll
        for (int lt = 0; lt < 2; ++lt) { const float el = __expf(acsl[lt]);
#pragma unroll
            for (int pt = 0; pt < 4; ++pt) y[pt][lt] *= el; }
    }
#pragma unroll
    for (int ks = 0; ks < 4; ++ks) if (ks <= wid) {
        const int j0 = ks * 32 + 8 * fq;
        const f32x4 aj0 = *(const f32x4*)(par_acs + j0), aj1 = *(const f32x4*)(par_acs + j0 + 4), dj0 = *(const f32x4*)(par_dt + j0), dj1 = *(const f32x4*)(par_dt + j0 + 4);
        bf16x8 mf[2];
#pragma unroll
        for (int lt = 0; lt < 2; ++lt) {
            const int l = lrow0 + 16 * lt;
            const u32x4 raw = cbr[ks][lt];
            float m[8];
#pragma unroll
            for (int e = 0; e < 4; ++e) { m[2 * e] = __uint_as_float(raw[e] << 16); m[2 * e + 1] = __uint_as_float(raw[e] & 0xFFFF0000u); }
#pragma unroll
            for (int e = 0; e < 8; ++e) { const float aj = e < 4 ? aj0[e & 3] : aj1[e & 3], dj = e < 4 ? dj0[e & 3] : dj1[e & 3];
                m[e] = (j0 + e <= l) ? m[e] * __expf(acsl[lt] - aj) * dj : 0.f; }
            u32x4 pk; pk.x = pack_bf2(m[0], m[1]); pk.y = pack_bf2(m[2], m[3]); pk.z = pack_bf2(m[4], m[5]); pk.w = pack_bf2(m[6], m[7]);
            mf[lt] = __builtin_bit_cast(bf16x8, pk);
        }
#pragma unroll
        for (int pt = 0; pt < 4; ++pt) {
            const bf16x8 xf = *(const bf16x8*)(X + (pt * 16 + fr) * 256 + (((ks * 4 + fq) ^ fr) * 16));
            y[pt][0] = __builtin_amdgcn_mfma_f32_16x16x32_bf16(xf, mf[0], y[pt][0], 0, 0, 0);
            y[pt][1] = __builtin_amdgcn_mfma_f32_16x16x32_bf16(xf, mf[1], y[pt][1], 0, 0, 0);
        }
    }
#pragma unroll
    for (int lt = 0; lt < 2; ++lt) {
        const size_t tok = tokb + lrow0 + 16 * lt;
        const int lq = lrow0 + 16 * lt;
        float ss = 0.f;
#pragma unroll
        for (int pt = 0; pt < 4; ++pt) {
            const int col = h * 64 + pt * 16 + 4 * fq;
            const u32x2 zq = zr[lt][pt];
            float xv[4];
#pragma unroll
            for (int e = 0; e < 4; ++e) { const int pr = pt * 16 + 4 * fq + e; xv[e] = bf2f(*(const bf16*)(X + pr * 256 + (((lq >> 3) ^ (pr & 15)) * 16) + (lq & 7) * 2)); }
            const float zv[4] = {__uint_as_float(zq.x << 16), __uint_as_float(zq.x & 0xFFFF0000u), __uint_as_float(zq.y << 16), __uint_as_float(zq.y & 0xFFFF0000u)};
            float gv[4];
#pragma unroll
            for (int e = 0; e < 4; ++e) { gv[e] = (y[pt][lt][e] + Dh * xv[e]) * silu_f(zv[e]); ss += gv[e] * gv[e]; }
            u32x2 o; o.x = pack_bf2(gv[0], gv[1]); o.y = pack_bf2(gv[2], gv[3]);
            *(u32x2*)(WS(bf16, OFF_R1) + tok * 1024 + 512 + col) = o;
        }
        ss += __shfl_xor(ss, 16); ss += __shfl_xor(ss, 32);
        if (fq == 0) atomicAdd(WS(float, OFF_SSQ) + tok * 2 + g, ss);
    }
    half_sync();
}

__device__ __forceinline__ u32 cvt_pk_bf16(float lo, float hi) { return pack_bf2(lo, hi); }
__device__ __forceinline__ void attn_stage(const bf16* Kb, const bf16* Vb, int kt, unsigned char* st, int wid, int lane) {
#pragma unroll
    for (int i = 0; i < 4; ++i) {
        const int piece = wid * 4 + i, c = piece >> 3, r = (piece & 7) * 8 + (lane >> 3), ch = (lane & 7) ^ (r & 7);
        __builtin_amdgcn_global_load_lds((const u32*)(Kb + (size_t)(kt * 64 + r) * 512 + c * 64 + ch * 8), (u32*)(st + piece * 1024 + lane * 16), 16, 0, 0);
        const int rv = piece * 8 + (lane >> 3), chv = (lane & 7) ^ ((rv >> 1) & 7);
        __builtin_amdgcn_global_load_lds((const u32*)(Vb + (size_t)rv * SEQ + kt * 64 + chv * 8), (u32*)(st + 16384 + piece * 1024 + lane * 16), 16, 0, 0);
    }
}
__device__ __forceinline__ void attn_unit(const P& p, int qb, int bh, unsigned char* lds) {
    const int tid = tidx(), wid = tid >> 6, lane = tid & 63, fr = lane & 15, fq = lane >> 4;
    const int b = bh >> 2, h = bh & 3;
    const bf16* Kb = WS(bf16, OFF_KR) + (size_t)b * SEQ * 512 + h * 128;
    const bf16* Vb = WS(bf16, OFF_VTT) + (size_t)bh * 128 * SEQ;
    const int qrow = qb * 64 + wid * 16 + fr;
    const bf16* qp = WS(bf16, OFF_QR) + ((size_t)b * SEQ + qrow) * 512 + h * 128 + 8 * fq;
    bf16x8 qf[2][2];
#pragma unroll
    for (int c = 0; c < 2; ++c)
#pragma unroll
        for (int ks = 0; ks < 2; ++ks) qf[c][ks] = *(const bf16x8*)(qp + c * 64 + ks * 32);
    f32x4 O[2][8];
#pragma unroll
    for (int c = 0; c < 2; ++c)
#pragma unroll
        for (int d = 0; d < 8; ++d) O[c][d] = (f32x4){0.f, 0.f, 0.f, 0.f};
    float mrun[2] = {-1e30f, -1e30f}, lrun[2] = {0.f, 0.f};
    const int ntile = qb + 1;
    attn_stage(Kb, Vb, 0, lds, wid, lane);
    for (int kt = 0; kt < ntile; ++kt) {
        const unsigned char* cur = lds + (kt & 1) * 32768;
        asm volatile("s_waitcnt vmcnt(0)" ::: "memory");
        half_sync();
        if (kt + 1 < ntile) attn_stage(Kb, Vb, kt + 1, lds + ((kt + 1) & 1) * 32768, wid, lane);
        f32x4 s[2][4];
#pragma unroll
        for (int c = 0; c < 2; ++c)
#pragma unroll
            for (int nt = 0; nt < 4; ++nt) {
                s[c][nt] = (f32x4){0.f, 0.f, 0.f, 0.f};
#pragma unroll
                for (int ks = 0; ks < 2; ++ks) {
                    const int r = nt * 16 + fr;
                    const bf16x8 kf = *(const bf16x8*)(cur + c * 8192 + r * 128 + (((ks * 4 + fq) ^ (r & 7)) * 16));
                    s[c][nt] = __builtin_amdgcn_mfma_f32_16x16x32_bf16(kf, qf[c][ks], s[c][nt], 0, 0, 0);
                }
            }
        if (kt == ntile - 1) {
            const int ql = wid * 16 + fr;
#pragma unroll
            for (int c = 0; c < 2; ++c)
#pragma unroll
                for (int nt = 0; nt < 4; ++nt)
#pragma unroll
                    for (int j = 0; j < 4; ++j) if (nt * 16 + 4 * fq + j > ql) s[c][nt][j] = -1e30f;
        }
        bf16x8 pf[2][2];
        float mxa[2], alpha[2];
#pragma unroll
        for (int c = 0; c < 2; ++c) {
            float t4[4];
#pragma unroll
            for (int nt = 0; nt < 4; ++nt) t4[nt] = fmaxf(fmaxf(s[c][nt][0], s[c][nt][1]), fmaxf(s[c][nt][2], s[c][nt][3]));
            mxa[c] = fmaxf(fmaxf(t4[0], t4[1]), fmaxf(t4[2], t4[3]));
        }
        mxa[0] = quad_max(mxa[0]); mxa[1] = quad_max(mxa[1]);
#pragma unroll
        for (int c = 0; c < 2; ++c) {
            const bool mv = mxa[c] > mrun[c] + 8.0f; const float mn = mv ? mxa[c] : mrun[c];
            alpha[c] = mv ? __builtin_amdgcn_exp2f(mrun[c] - mn) : 1.0f; mrun[c] = mn; }
#pragma unroll
        for (int c = 0; c < 2; ++c)
#pragma unroll
            for (int nt = 0; nt < 4; ++nt)
#pragma unroll
                for (int j = 0; j < 4; ++j) s[c][nt][j] = __builtin_amdgcn_exp2f(s[c][nt][j] - mrun[c]);
#pragma unroll
        for (int c = 0; c < 2; ++c) {
            float t4[4];
#pragma unroll
            for (int nt = 0; nt < 4; ++nt) t4[nt] = (s[c][nt][0] + s[c][nt][1]) + (s[c][nt][2] + s[c][nt][3]);
            lrun[c] = lrun[c] * alpha[c] + ((t4[0] + t4[1]) + (t4[2] + t4[3]));
#pragma unroll
            for (int ks = 0; ks < 2; ++ks) {
                u32x4 w; w.x = cvt_pk_bf16(s[c][2 * ks][0], s[c][2 * ks][1]); w.y = cvt_pk_bf16(s[c][2 * ks][2], s[c][2 * ks][3]);
                w.z = cvt_pk_bf16(s[c][2 * ks + 1][0], s[c][2 * ks + 1][1]); w.w = cvt_pk_bf16(s[c][2 * ks + 1][2], s[c][2 * ks + 1][3]);
                pf[c][ks] = __builtin_bit_cast(bf16x8, w);
            }
        }
        if (__any(alpha[0] != 1.0f || alpha[1] != 1.0f)) {
#pragma unroll
            for (int d = 0; d < 8; ++d) { O[0][d] *= alpha[0]; O[1][d] *= alpha[1]; }
        }
#pragma unroll
        for (int d = 0; d < 8; ++d)
#pragma unroll
            for (int ks = 0; ks < 2; ++ks) {
                const int r = d * 16 + fr, sw = (r >> 1) & 7, ch = 4 * ks + (fq >> 1);
                const unsigned char* rowp = cur + 16384 + r * 128 + (fq & 1) * 8;
                const u32x2 v0 = *(const u32x2*)(rowp + ((ch ^ sw) * 16)), v1 = *(const u32x2*)(rowp + (((ch + 2) ^ sw) * 16));
                const bf16x8 vf = __builtin_bit_cast(bf16x8, (u32x4){v0.x, v0.y, v1.x, v1.y});
                O[0][d] = __builtin_amdgcn_mfma_f32_16x16x32_bf16(vf, pf[0][ks], O[0][d], 0, 0, 0);
                O[1][d] = __builtin_amdgcn_mfma_f32_16x16x32_bf16(vf, pf[1][ks], O[1][d], 0, 0, 0);
            }
    }
    float l0 = lrun[0], l1 = lrun[1];
    l0 = quad_sum(l0); l1 = quad_sum(l1);
    const float i0 = 1.0f / l0, i1 = WS(float, OFF_LAM)[0] / l1;
    float ss = 0.f;
#pragma unroll
    for (int d = 0; d < 8; ++d) { O[0][d] = O[0][d] * i0 - O[1][d] * i1; ss += O[0][d][0] * O[0][d][0] + O[0][d][1] * O[0][d][1] + O[0][d][2] * O[0][d][2] + O[0][d][3] * O[0][d][3]; }
    ss = quad_sum(ss);
    const float rn = rsqrtf(ss * (1.0f / 128.0f) + 1e-5f) * (1.0f - LAMBDA_INIT);
    bf16* orow = WS(bf16, OFF_R1) + ((size_t)b * SEQ + qrow) * 1024 + h * 128 + 4 * fq;
#pragma unroll
    for (int d = 0; d < 8; ++d) {
        const f32x4 g = *(const f32x4*)(p.subln_g + d * 16 + 4 * fq);
        const f32x4 o = O[0][d] * g * rn;
        u32x2 w; w.x = cvt_pk_bf16(o[0], o[1]); w.y = cvt_pk_bf16(o[2], o[3]);
        *(u32x2*)(orow + d * 16) = w;
    }
    half_sync();
}
__device__ __forceinline__ void ph_mix(const P& p, unsigned char* lds, unsigned xcc) {
    unsigned* qc = (unsigned*)(p.ws + OFF_CTRL + 14336);
    unsigned* done = (unsigned*)(p.ws + OFF_CTRL + 14336 + 1024);
    unsigned* qo = (unsigned*)(p.ws + OFF_CTRL + 14336 + 1280);
    unsigned* qq = (unsigned*)(p.ws + OFF_CTRL + 14336 + 1536);
    unsigned* qa = (unsigned*)(p.ws + OFF_CTRL + 20480);
    volatile unsigned* slot = wg_slot();
    for (;;) { const unsigned it = queue_next(qc, slot); if (it >= 128u) break; ssd_state_unit(p, it, lds); }
    for (unsigned off = 0; off < 8u; ++off) {
        const unsigned x = (xcc + off) & 7u;
        for (;;) {
            const unsigned it = queue_next(qa + 64 * x, slot);
            if (it >= 256u) break;
            attn_unit(p, 31 - (int)(it & 31u), (int)(x + 8u * (it >> 5)), lds);
        }
    }
    for (;;) { const unsigned it = queue_next(qq, slot); if (it >= 2048u) break; k_quant_tables(p, it); }
    {
        if (tidx() == 0) {
            unsigned spins = 0;
            while (__hip_atomic_load(done, __ATOMIC_RELAXED, __HIP_MEMORY_SCOPE_AGENT) < 128u) { __builtin_amdgcn_s_sleep(2); if (++spins > (1u << 22)) break; }
            __builtin_amdgcn_fence(__ATOMIC_ACQUIRE, "agent");
            asm volatile("s_waitcnt vmcnt(0)" ::: "memory");
        }
        half_sync();
    }
    for (;;) { const unsigned it = queue_next(qo, slot); if (it >= 2048u) break; ssd_out_unit(p, it, lds); }
}
#define XB_TMO      128
#define XB_XCNT(j)  (256  + 64 * (j))
#define XB_XSUB(j)  (1280 + 64 * (j))
#define XB_XGEN(j)  (2304 + 64 * (j))
#define XB_TOP      3328
#define XB_TOPGEN   3392
#define XCD_BAR_WORDS 3456
#define XB_SPIN_CAP (1u << 18)
#define LAS __attribute__((address_space(3)))
__device__ __forceinline__ unsigned xb_ld(unsigned* p)              { return __hip_atomic_load(p, __ATOMIC_RELAXED, __HIP_MEMORY_SCOPE_AGENT); }
__device__ __forceinline__ unsigned xb_add(unsigned* p, unsigned v) { return __hip_atomic_fetch_add(p, v, __ATOMIC_RELAXED, __HIP_MEMORY_SCOPE_AGENT); }
__device__ __forceinline__ unsigned xb_xcc_id() { return (unsigned)__builtin_amdgcn_s_getreg((3 << 11) | 20) & 0xFu; }
#define XB_SPIN(cond, bar) do { unsigned _sp = 0; while (cond) { __builtin_amdgcn_s_sleep(1); \
    if ((++_sp & 255u) == 0u) { if (xb_ld(&(bar)[XB_TMO])) break; if (_sp > XB_SPIN_CAP) { atomicAdd(&(bar)[XB_TMO], 1u); break; } } } } while (0)
struct XcdBarrier { unsigned* bar; unsigned x; volatile LAS unsigned* st; };
__device__ __forceinline__ XcdBarrier xcd_barrier_post(unsigned* bar, volatile LAS unsigned* st) {
    XcdBarrier b; b.bar = bar; b.x = xb_xcc_id(); b.st = st;
    if (rtid() == 0) (void)xb_add(&bar[XB_XCNT(b.x)], 1u);
    return b;
}
__device__ __forceinline__ void xcd_barrier_complete(unsigned* bar, unsigned x, unsigned& nloc, unsigned& nx) {
    const unsigned G = gridDim.x * gridDim.y * gridDim.z;
    unsigned sum, cnt, mine, sp = 0u;
    for (;;) {
        sum = 0u; cnt = 0u; mine = 0u;
#pragma unroll
        for (unsigned j = 0; j < 16; ++j) { const unsigned c = xb_ld(&bar[XB_XCNT(j)]); sum += c; cnt += (c > 0u) ? 1u : 0u; mine = (j == x) ? c : mine; }
        if (sum == G) break;
        __builtin_amdgcn_s_sleep(1);
        if ((++sp & 255u) == 0u) { if (xb_ld(&bar[XB_TMO])) break; if (sp > XB_SPIN_CAP) { atomicAdd(&bar[XB_TMO], 1u); break; } }
    }
    nloc = mine > 0u ? mine : 1u; nx = cnt > 0u ? cnt : 1u;
}
__device__ __forceinline__ void xcd_barrier(const XcdBarrier& b) {
    asm volatile("s_waitcnt vmcnt(0)" ::: "memory");
    __syncthreads();
    if (rtid() == 0) {
        unsigned* bar = b.bar;
        __builtin_amdgcn_s_waitcnt(0);
        unsigned nloc = b.st[0], nx = b.st[1];
        if (nloc == 0u) { xcd_barrier_complete(bar, b.x, nloc, nx); b.st[0] = nloc; b.st[1] = nx; }
        const unsigned old = xb_add(&bar[XB_XSUB(b.x)], 1u);
        const unsigned gen = old / nloc;
        if (old + 1u == (gen + 1u) * nloc) {
            __builtin_amdgcn_fence(__ATOMIC_RELEASE, "agent");
            asm volatile("s_waitcnt vmcnt(0)" ::: "memory");
            const unsigned og = xb_add(&bar[XB_TOP], 1u);
            const unsigned tg = og / nx;
            if (og + 1u == (tg + 1u) * nx) xb_add(&bar[XB_TOPGEN], 1u);
            else XB_SPIN(xb_ld(&bar[XB_TOPGEN]) == tg, bar);
            __builtin_amdgcn_fence(__ATOMIC_ACQUIRE, "agent");
            xb_add(&bar[XB_XGEN(b.x)], 1u);
            asm volatile("s_waitcnt vmcnt(0)" ::: "memory");
        } else {
            XB_SPIN(xb_ld(&bar[XB_XGEN(b.x)]) == gen, bar);
            __builtin_amdgcn_fence(__ATOMIC_ACQUIRE, "agent");
            asm volatile("s_waitcnt vmcnt(0)" ::: "memory");
        }
    }
    __syncthreads();
}

#define RUN(fn, n) do { for (unsigned vb_ = VBID; vb_ < (unsigned)(n); vb_ += VGRID) { fn(p, vb_, (unsigned)(n)); __syncthreads(); } } while (0)
__global__ void __launch_bounds__(512, 2) k_mega(P p) {
    unsigned char* smem = g_smem;
    unsigned char* lds = smem + vhalf() * LDS_MAIN;
    if (rtid() < 80u) *(unsigned*)(smem + 2 * LDS_MAIN + 4 * rtid()) = 0u;
    __syncthreads();
    XcdBarrier bar = xcd_barrier_post((unsigned*)(p.ws + OFF_CTRL), (volatile LAS unsigned*)(smem + 2 * LDS_MAIN));
    ph_prep(p, lds);
    xcd_barrier(bar);
    ph_inproj8(p);
    xcd_barrier(bar);
    ph_conv(p, lds);
    xcd_barrier(bar);
    ph_mix(p, lds, bar.x);
    xcd_barrier(bar);
    ph_ssd_finalize(p);
    xcd_barrier(bar);
    ph_outproj8(p);
    xcd_barrier(bar);
    ph_peerq8(p);
    xcd_barrier(bar);
    for (unsigned u = VBID; u < (unsigned)(NT / 32); u += VGRID) peer_route_unit(p, u, lds);
    xcd_barrier(bar);
    { unsigned* q = (unsigned*)(p.ws + OFF_CTRL + 16384); volatile unsigned* slot = wg_slot();
      sliced_units(q, bar.x, slot, [&](unsigned t, unsigned s) { peer_u_unit(p, t, s, lds); }); }
    xcd_barrier(bar);
    ph_peer_coef(p);
    xcd_barrier(bar);
    { unsigned* q = (unsigned*)(p.ws + OFF_CTRL + 16384 + 2048); volatile unsigned* slot = wg_slot();
      sliced_units(q, bar.x, slot, [&](unsigned t, unsigned s) { peer_v_unit(p, t, s, lds); }); }
    xcd_barrier(bar);
    ph_ln2(p);
}

extern "C" void kernel_launch(void* const* d_in, const int* in_sizes, int n_in, void* d_out, int out_size, void* d_ws, size_t ws_size, hipStream_t stream) {
    P p{};
    p.x = (const float*)d_in[0]; p.pos = (const int*)d_in[1]; p.w_in = (const float*)d_in[2]; p.w_out = (const float*)d_in[3];
    p.lq1 = (const float*)d_in[4]; p.lk1 = (const float*)d_in[5]; p.lq2 = (const float*)d_in[6]; p.lk2 = (const float*)d_in[7]; p.subln_g = (const float*)d_in[8];
    p.conv_w = (const float*)d_in[9]; p.conv_b = (const float*)d_in[10]; p.dt_bias = (const float*)d_in[11]; p.a_log = (const float*)d_in[12]; p.d_skip = (const float*)d_in[13];
    p.ssd_norm_g = (const float*)d_in[14]; p.ln1_g = (const float*)d_in[15]; p.ln1_b = (const float*)d_in[16]; p.peer_wq = (const float*)d_in[17]; p.peer_keys = (const float*)d_in[18];
    p.peer_u = (const float*)d_in[19]; p.peer_v = (const float*)d_in[20]; p.ln2_g = (const float*)d_in[21]; p.ln2_b = (const float*)d_in[22];
    p.out = (float*)d_out; p.ws = (unsigned char*)d_ws;
    static int grid = 0;
    if (!grid) {
        int dev = 0, cus = 0, per_cu = 0;
        (void)hipGetDevice(&dev);
        (void)hipDeviceGetAttribute(&cus, hipDeviceAttributeMultiprocessorCount, dev);
        (void)hipFuncSetAttribute((const void*)k_mega, hipFuncAttributeMaxDynamicSharedMemorySize, (int)LDS_BYTES);
        (void)hipOccupancyMaxActiveBlocksPerMultiprocessor(&per_cu, k_mega, 512, LDS_BYTES);
        grid = cus * (per_cu < 1 ? per_cu : 1);
    }
    (void)hipMemsetAsync(d_ws, 0, 24576, stream);
    k_mega<<<grid, 512, LDS_BYTES, stream>>>(p);
}
```

```cpp
#include <hip/hip_runtime.h>
#include <stdint.h>
#include <type_traits>

typedef unsigned short bf16;
typedef unsigned int u32;
typedef short bf16x8 __attribute__((ext_vector_type(8)));
typedef float f32x4 __attribute__((ext_vector_type(4)));
typedef float f32x2 __attribute__((ext_vector_type(2)));
typedef unsigned u32x2 __attribute__((ext_vector_type(2)));
typedef unsigned u32x4 __attribute__((ext_vector_type(4)));

constexpr int NB = 16, SEQ = 2048, DM = 1024, NT = NB * SEQ;
constexpr int NIN = 3080;
constexpr float ALPHA = 1.189207115002721f;
constexpr float LAMBDA_INIT = 0.2f;
constexpr unsigned LDS_MAIN = 73728;
constexpr unsigned LDS_BYTES = 2 * LDS_MAIN + 64 + 256;

__device__ __forceinline__ unsigned rtid() { unsigned t = threadIdx.x; asm volatile("" : "+v"(t)); return t; }
__device__ __forceinline__ unsigned tidx() { return rtid() & 255u; }
__device__ __forceinline__ unsigned vhalf() { return (unsigned)__builtin_amdgcn_readfirstlane((int)(threadIdx.x >> 8)); }
#define VBID (blockIdx.x * 2u + vhalf())
#define VGRID (gridDim.x * 2u)
#define LAS3 __attribute__((address_space(3)))
extern __shared__ __attribute__((aligned(16))) unsigned char g_smem[];
__device__ __forceinline__ volatile unsigned* wg_slot() { return (volatile unsigned*)(g_smem + 2 * LDS_MAIN + 64 + vhalf() * 128 + 64); }
__device__ __forceinline__ void half_sync() {
    asm volatile("s_waitcnt lgkmcnt(0)" ::: "memory");
    LAS3 unsigned* c = (LAS3 unsigned*)(g_smem + 2 * LDS_MAIN + 64 + vhalf() * 128);
    unsigned target = 0u;
    if ((threadIdx.x & 63u) == 0u) target = (__hip_atomic_fetch_add(c, 1u, __ATOMIC_RELAXED, __HIP_MEMORY_SCOPE_WORKGROUP) & ~3u) + 4u;
    target = (unsigned)__builtin_amdgcn_readfirstlane((int)target);
    while ((unsigned)__builtin_amdgcn_readfirstlane((int)__hip_atomic_load(c, __ATOMIC_RELAXED, __HIP_MEMORY_SCOPE_WORKGROUP)) < target) __builtin_amdgcn_s_sleep(0);
    asm volatile("s_waitcnt lgkmcnt(0)" ::: "memory");
}
__device__ __forceinline__ bf16 f2bf(float f) { u32 u = __float_as_uint(f); u += 0x7FFFu + ((u >> 16) & 1u); return (bf16)(u >> 16); }
typedef __bf16 bf2v_t __attribute__((ext_vector_type(2)));
__device__ __forceinline__ u32 pack_bf2(float lo, float hi) { bf2v_t v; v.x = (__bf16)lo; v.y = (__bf16)hi; return __builtin_bit_cast(u32, v); }
__device__ __forceinline__ float bf2f(bf16 h) { return __uint_as_float(((u32)h) << 16); }
__device__ __forceinline__ float silu_f(float v) { return v / (1.0f + __expf(-v)); }
__device__ __forceinline__ float wave_sum(float v) {
#pragma unroll
    for (int o = 32; o > 0; o >>= 1) v += __shfl_xor(v, o);
    return v;
}
__device__ __forceinline__ float wave_incl_scan(float v, int lane) {
#pragma unroll
    for (int o = 1; o < 64; o <<= 1) { const float t = __shfl_up(v, o); if (lane >= o) v += t; }
    return v;
}
__device__ __forceinline__ float wave_max(float v) {
#pragma unroll
    for (int o = 32; o > 0; o >>= 1) v = fmaxf(v, __shfl_xor(v, o));
    return v;
}

constexpr size_t MiB = 1024 * 1024;
constexpr size_t OFF_CTRL = 0;
constexpr size_t OFF_WINT = 1 * MiB;
constexpr size_t OFF_WOUTT = 7 * MiB;
constexpr size_t OFF_WQT = 9 * MiB;
constexpr size_t OFF_KEYS = 13 * MiB;
constexpr size_t OFF_LAM = 13 * MiB + 512 * 1024;
constexpr size_t OFF_DT = 14 * MiB;
constexpr size_t OFF_SSQ = 15 * MiB;
constexpr size_t OFF_STAT1 = 15 * MiB + 512 * 1024;
constexpr size_t OFF_COLSUM = 13 * MiB + 576 * 1024;
constexpr size_t OFF_BIASQ = 13 * MiB + 592 * 1024;
constexpr size_t OFF_ROPEC = 16 * MiB;
constexpr size_t OFF_ROPES = 20 * MiB;
constexpr size_t OFF_UQ = 24 * MiB;
constexpr size_t OFF_VQ = 40 * MiB;
constexpr size_t OFF_SU = 56 * MiB;
constexpr size_t OFF_SV = 56 * MiB + 65536;
constexpr size_t OFF_R1 = 88 * MiB;
constexpr size_t OFF_R2 = 152 * MiB;
constexpr size_t OFF_QR = OFF_R2;
constexpr size_t OFF_KR = OFF_R2 + 32 * MiB;
constexpr size_t OFF_VTT = OFF_R2 + 64 * MiB;
constexpr size_t OFF_Z = OFF_R2 + 96 * MiB;
constexpr size_t OFF_XBC = OFF_R2 + 128 * MiB;
constexpr size_t OFF_Y1B = OFF_R2 + 128 * MiB;
constexpr size_t OFF_PQ = OFF_R2;
constexpr size_t OFF_R3 = 344 * MiB;
constexpr size_t OFF_XS = OFF_R3;
constexpr size_t OFF_XT = OFF_R3 + 32 * MiB;
constexpr size_t OFF_BT = OFF_R3 + 64 * MiB;
constexpr size_t OFF_CN = OFF_R3 + 80 * MiB;
constexpr size_t OFF_CB = OFF_R3 + 96 * MiB;
constexpr size_t OFF_IDSP = OFF_R3;
constexpr size_t OFF_GATEP = OFF_R3 + 8 * MiB;
constexpr size_t OFF_HQ = OFF_R3 + 24 * MiB;
constexpr size_t OFF_COEF = OFF_R3 + 56 * MiB;
constexpr size_t OFF_CSC = OFF_R3 + 60 * MiB;
constexpr size_t OFF_HSC = OFF_R3 + 72 * MiB;
constexpr size_t OFF_STAT = OFF_R3 + 73 * MiB;
constexpr size_t OFF_Y2B = 420 * MiB;
constexpr size_t OFF_PD = OFF_R2;
constexpr size_t OFF_WL = 488 * MiB;
constexpr size_t OFF_TOT = 489 * MiB;
constexpr size_t OFF_PREV = 456 * MiB;

struct P {
    const float* x; const int* pos; const float* w_in; const float* w_out;
    const float* lq1; const float* lk1; const float* lq2; const float* lk2; const float* subln_g;
    const float* conv_w; const float* conv_b; const float* dt_bias; const float* a_log; const float* d_skip;
    const float* ssd_norm_g; const float* ln1_g; const float* ln1_b; const float* peer_wq; const float* peer_keys;
    const float* peer_u; const float* peer_v; const float* ln2_g; const float* ln2_b;
    float* out; unsigned char* ws;
};
#define WS(T, off) ((T*)(p.ws + (off)))

__device__ __forceinline__ void ph_prep(const P& p, unsigned char* lds) {
    const int tid = tidx(), wid = tid >> 6, lane = tid & 63;
    float* wdt = (float*)lds;
    for (int idx = tid; idx < 8192; idx += 256) { const int k = idx >> 3, j = idx & 7; wdt[j * 1024 + k] = p.w_in[(size_t)k * NIN + 3072 + j]; }
    half_sync();
    const float inv_freq = powf(10000.0f, -(float)(2 * (lane & 31)) / 64.0f);
    for (unsigned tb = (VBID * 4 + wid) * 2; tb < (unsigned)NT; tb += VGRID * 8) {
        f32x4 xv[2][4]; int pos[2];
#pragma unroll
        for (int q = 0; q < 2; ++q) { pos[q] = p.pos[tb + q];
#pragma unroll
            for (int i = 0; i < 4; ++i) xv[q][i] = *(const f32x4*)(p.x + (size_t)(tb + q) * DM + 256 * i + 4 * lane); }
#pragma unroll
        for (int q = 0; q < 2; ++q) {
            const unsigned tok = tb + q;
            bf16* xb = WS(bf16, OFF_R1) + (size_t)tok * DM;
            float acc[8];
#pragma unroll
            for (int j = 0; j < 8; ++j) acc[j] = 0.f;
#pragma unroll
            for (int i = 0; i < 4; ++i) {
                const int k = 256 * i + 4 * lane;
                const f32x4 v = xv[q][i];
                u32x2 o; o.x = pack_bf2(v[0], v[1]); o.y = pack_bf2(v[2], v[3]);
                *(u32x2*)(xb + k) = o;
#pragma unroll
                for (int j = 0; j < 8; ++j) { const f32x4 w = *(const f32x4*)(wdt + j * 1024 + k); acc[j] += v[0] * w[0] + v[1] * w[1] + v[2] * w[2] + v[3] * w[3]; }
            }
#pragma unroll
            for (int j = 0; j < 8; ++j) acc[j] = wave_sum(acc[j]);
            if (lane < 8) {
                float v = 0.f;
#pragma unroll
                for (int j = 0; j < 8; ++j) if (lane == j) v = acc[j];
                v += p.dt_bias[lane];
                WS(float, OFF_DT)[(size_t)tok * 8 + lane] = fmaxf(v, 0.f) + log1pf(expf(-fabsf(v)));
            }
            if (lane < 32) {
                const float ang = (float)pos[q] * inv_freq;
                WS(float, OFF_ROPEC)[(size_t)tok * 32 + lane] = cosf(ang);
                WS(float, OFF_ROPES)[(size_t)tok * 32 + lane] = sinf(ang);
            }
            if (tok == 0 && lane == 0) {
                float s1 = 0.f, s2 = 0.f;
                for (int i = 0; i < 64; ++i) { s1 += p.lq1[i] * p.lk1[i]; s2 += p.lq2[i] * p.lk2[i]; }
                WS(float, OFF_LAM)[0] = expf(s1) - expf(s2) + LAMBDA_INIT;
            }
            if (lane < 2) { WS(float, OFF_SSQ)[(size_t)tok * 2 + lane] = 0.f; WS(float, OFF_STAT1)[(size_t)tok * 2 + lane] = 0.f; }
        }
    }
    half_sync();
    float* tile = (float*)lds;
    for (unsigned t = VBID; t < 1536u; t += VGRID) {
        const float* srcp; bf16* dst; int ld, kt, nt; bool og = false, qg = false;
        if (t < 768u) { srcp = p.w_in; dst = WS(bf16, OFF_WINT); ld = NIN; kt = (int)(t % 16u); nt = (int)(t / 16u); }
        else if (t < 1024u) { const unsigned q = t - 768u; srcp = p.w_out; dst = WS(bf16, OFF_WOUTT); ld = 1024; kt = (int)(q % 16u); nt = (int)(q / 16u); og = true; }
        else { const unsigned q = t - 1024u; srcp = p.peer_wq; dst = WS(bf16, OFF_WQT); ld = 2048; kt = (int)(q % 16u); nt = (int)(q / 16u); qg = true; }
#pragma unroll
        for (int i = 0; i < 4; ++i) {
            const int kr = i * 16 + (tid >> 4), nc = (tid & 15) * 4;
            const f32x4 v = *(const f32x4*)(srcp + (size_t)(kt * 64 + kr) * ld + nt * 64 + nc);
            float sc = 1.0f; if (og && kt * 64 + kr >= 512) sc = p.ssd_norm_g[kt * 64 + kr - 512]; if (qg) sc = p.ln1_g[kt * 64 + kr];
            tile[kr * 65 + nc] = v[0] * sc; tile[kr * 65 + nc + 1] = v[1] * sc; tile[kr * 65 + nc + 2] = v[2] * sc; tile[kr * 65 + nc + 3] = v[3] * sc;
        }
        half_sync();
#pragma unroll
        for (int i = 0; i < 2; ++i) {
            const int item = tid + 256 * i, n = item & 63, kg = item >> 6;
            float e[8];
#pragma unroll
            for (int q = 0; q < 8; ++q) e[q] = tile[(kg * 8 + q) * 65 + n];
            u32x4 o; o.x = pack_bf2(e[0], e[1]); o.y = pack_bf2(e[2], e[3]); o.z = pack_bf2(e[4], e[5]); o.w = pack_bf2(e[6], e[7]);
            int prow = nt * 64 + n;
            if (t < 768u && nt < 16) prow = nt * 64 + ((n & 15) | ((n & 16) << 1) | ((n & 32) >> 1));
            *(u32x4*)(dst + (size_t)prow * 1024 + kt * 64 + kg * 8) = o;
        }
        half_sync();
    }
    for (size_t i = (size_t)VBID * 256 + tid; i < (size_t)8 * 2 * 128 * 128; i += (size_t)VGRID * 256) WS(bf16, OFF_KEYS)[i] = f2bf(p.peer_keys[i]);
    for (unsigned t = VBID; t < 128u; t += VGRID) {
        const int n = (int)t * 16 + (tid & 15), ksl = tid >> 4;
        float cs = 0.f, bs = 0.f;
#pragma unroll 16
        for (int k = ksl * 64; k < ksl * 64 + 64; ++k) { const float w = p.peer_wq[(size_t)k * 2048 + n]; cs += bf2f(f2bf(w * p.ln1_g[k])); bs += w * p.ln1_b[k]; }
        float* red = (float*)lds;
        half_sync();
        red[tid] = cs; red[256 + tid] = bs;
        half_sync();
        if (tid < 16) {
            float c2 = 0.f, b2 = 0.f;
#pragma unroll
            for (int s = 0; s < 16; ++s) { c2 += red[s * 16 + tid]; b2 += red[256 + s * 16 + tid]; }
            WS(float, OFF_COLSUM)[n] = c2; WS(float, OFF_BIASQ)[n] = b2;
        }
        half_sync();
    }
}

__device__ __forceinline__ void k_quant_tables(const P& p, const unsigned item) {
    const int wid = tidx() >> 6, lane = tidx() & 63;
    f32x4 xv[4][4];
#pragma unroll
    for (int q = 0; q < 4; ++q) {
        const unsigned r = (item * 4 + wid) * 4 + q; const bool isv = r >= 16384u; const unsigned row = isv ? r - 16384u : r;
        const float* srcp = (isv ? p.peer_v : p.peer_u) + (size_t)row * 1024 + lane * 16;
#pragma unroll
        for (int i = 0; i < 4; ++i) xv[q][i] = *(const f32x4*)(srcp + 4 * i);
    }
#pragma unroll
    for (int q = 0; q < 4; ++q) {
        const unsigned r = (item * 4 + wid) * 4 + q; const bool isv = r >= 16384u; const unsigned row = isv ? r - 16384u : r;
        float am = 0.f;
#pragma unroll
        for (int i = 0; i < 4; ++i)
#pragma unroll
            for (int e = 0; e < 4; ++e) am = fmaxf(am, fabsf(xv[q][i][e]));
        am = wave_max(am);
        const float inv = am > 0.f ? 127.0f / am : 0.f;
        u32x4 w;
#pragma unroll
        for (int i = 0; i < 4; ++i) { unsigned acc = 0u;
#pragma unroll
            for (int e = 0; e < 4; ++e) { const int qv = (int)rintf(xv[q][i][e] * inv); acc |= ((unsigned)qv & 0xFFu) << (8 * e); }
            w[i] = acc; }
        *(u32x4*)(p.ws + (isv ? OFF_VQ : OFF_UQ) + (size_t)row * 1024 + lane * 16) = w;
        if (lane == 0) WS(float, isv ? OFF_SV : OFF_SU)[row] = am * (1.0f / 127.0f);
    }
}


__device__ __forceinline__ void gemm_stage(const bf16* A, const bf16* Bt, int K, int row0, int col0, int kt, unsigned char* st, int wid, int lane) {
    const int c = (lane & 7) ^ (lane >> 3);
#pragma unroll
    for (int i = 0; i < 4; ++i) {
        const int piece = wid * 4 + i, r = piece * 8 + (lane >> 3);
        __builtin_amdgcn_global_load_lds((const u32*)(A + (size_t)(row0 + r) * K + kt * 64 + c * 8), (u32*)(st + piece * 1024 + lane * 16), 16, 0, 0);
        __builtin_amdgcn_global_load_lds((const u32*)(Bt + (size_t)(col0 + r) * K + kt * 64 + c * 8), (u32*)(st + 16384 + piece * 1024 + lane * 16), 16, 0, 0);
    }
}
template <bool RESC, class Epi>
__device__ __forceinline__ void gemm_tile(const bf16* A, const bf16* Bt, int K, int row0, int col0, unsigned char* lds, const float* ssq, const Epi& epi, bool first, int nrow0, int ncol0) {
    const int wid = tidx() >> 6, lane = tidx() & 63, wr = wid >> 1, wc = wid & 1, fr = lane & 15, fq = lane >> 4;
    f32x4 acc[4][4];
#pragma unroll
    for (int m = 0; m < 4; ++m)
#pragma unroll
        for (int n = 0; n < 4; ++n) acc[m][n] = (f32x4){0.f, 0.f, 0.f, 0.f};
    float r0[4], r1[4];
    if (RESC) {
#pragma unroll
        for (int m = 0; m < 4; ++m) { const f32x2 s = *(const f32x2*)(ssq + (size_t)(row0 + wr * 64 + m * 16 + fr) * 2); r0[m] = rsqrtf(s.x * (1.0f / 256.0f) + 1e-5f); r1[m] = rsqrtf(s.y * (1.0f / 256.0f) + 1e-5f); }
    }
    const int nt = K / 64;
    if (first) gemm_stage(A, Bt, K, row0, col0, 0, lds, wid, lane);
    for (int kt = 0; kt < nt; ++kt) {
        unsigned char* cur = lds + (kt & 1) * 32768;
        asm volatile("s_waitcnt vmcnt(0)" ::: "memory");
        half_sync();
        if (kt + 1 < nt) gemm_stage(A, Bt, K, row0, col0, kt + 1, lds + ((kt + 1) & 1) * 32768, wid, lane);
        else if (nrow0 >= 0) gemm_stage(A, Bt, K, nrow0, ncol0, 0, lds, wid, lane);
        if (RESC && (kt == 8 || kt == 12)) {
#pragma unroll
            for (int m = 0; m < 4; ++m) { const float f = (kt == 8) ? (1.0f / r0[m]) : (r0[m] / r1[m]);
#pragma unroll
                for (int n = 0; n < 4; ++n) acc[m][n] *= f; }
        }
        bf16x8 af[2][4], bfr[2][4];
#pragma unroll
        for (int ks = 0; ks < 2; ++ks) {
            const int coff = ((ks * 4 + fq) ^ (fr & 7)) * 16;
#pragma unroll
            for (int m = 0; m < 4; ++m) af[ks][m] = *(const bf16x8*)(cur + (wr * 64 + m * 16 + fr) * 128 + coff);
#pragma unroll
            for (int n = 0; n < 4; ++n) bfr[ks][n] = *(const bf16x8*)(cur + 16384 + (wc * 64 + n * 16 + fr) * 128 + coff);
        }
        __builtin_amdgcn_sched_barrier(0);
#pragma unroll
        for (int ks = 0; ks < 2; ++ks)
#pragma unroll
            for (int m = 0; m < 4; ++m)
#pragma unroll
                for (int n = 0; n < 4; ++n) acc[m][n] = __builtin_amdgcn_mfma_f32_16x16x32_bf16(bfr[ks][n], af[ks][m], acc[m][n], 0, 0, 0);
        __builtin_amdgcn_sched_barrier(0);
    }
    if (RESC) {
#pragma unroll
        for (int m = 0; m < 4; ++m)
#pragma unroll
            for (int n = 0; n < 4; ++n) acc[m][n] *= r1[m];
    }
    epi(acc, row0 + wr * 64 + fr, col0 + wc * 64 + 4 * fq);
    half_sync();
}
__device__ __forceinline__ void gemm_tile_coord(unsigned t, int nN, int& pm, int& pn) {
    const unsigned x = (t >> 1) & 7u, li = ((t >> 4) << 1) | (t & 1u), per_g = 32u * 8u, ng = li / per_g, rem = li % per_g;
    pm = (int)(x * 32u + rem / 8u); pn = (int)(ng * 8u + rem % 8u); (void)nN;
}
struct EpiInProj {
    const P& p;
    __device__ __forceinline__ void operator()(const f32x4 (&acc)[4][4], int row, int col) const {
        const int tile_col0 = col & ~127;
        if (tile_col0 < 1024) {
            const bool isq = tile_col0 < 512;
            bf16* dst = WS(bf16, isq ? OFF_QR : OFF_KR);
            const int hc0 = (col & 511) & ~63, i0 = col & 63;
            const float qs = isq ? 0.125f * 1.4426950408889634f : 1.0f;
#pragma unroll
            for (int m = 0; m < 4; ++m) {
                const size_t tok = (size_t)(row + 16 * m);
#pragma unroll
                for (int n = 0; n < 2; ++n) {
                    const int i = i0 + 16 * n;
                    const f32x4 cs = *(const f32x4*)(WS(float, OFF_ROPEC) + tok * 32 + i), sn = *(const f32x4*)(WS(float, OFF_ROPES) + tok * 32 + i);
                    const f32x4 x1 = acc[m][n], x2 = acc[m][n + 2];
                    const f32x4 o1 = (x1 * cs - x2 * sn) * qs, o2 = (x2 * cs + x1 * sn) * qs;
                    uint2 w1, w2; w1.x = pack_bf2(o1[0], o1[1]); w1.y = pack_bf2(o1[2], o1[3]); w2.x = pack_bf2(o2[0], o2[1]); w2.y = pack_bf2(o2[2], o2[3]);
                    *(uint2*)(dst + tok * 512 + hc0 + i) = w1; *(uint2*)(dst + tok * 512 + hc0 + i + 32) = w2;
                }
            }
        } else if (tile_col0 < 1536) {
#pragma unroll
            for (int m = 0; m < 4; ++m) {
                const int tok = row + 16 * m, b = tok >> 11, s = tok & 2047;
#pragma unroll
                for (int n = 0; n < 4; ++n)
#pragma unroll
                    for (int j = 0; j < 4; ++j) { const int c = col - 1024 + 16 * n + j; WS(bf16, OFF_VTT)[((size_t)b * 512 + c) * SEQ + s] = f2bf(acc[m][n][j]); }
            }
        } else {
            bf16* dst; int ld, c0;
            if (tile_col0 < 2048) { dst = WS(bf16, OFF_Z); ld = 512; c0 = col - 1536; } else { dst = WS(bf16, OFF_XBC); ld = 1024; c0 = col - 2048; }
#pragma unroll
            for (int m = 0; m < 4; ++m)
#pragma unroll
                for (int n = 0; n < 4; ++n) { uint2 w; w.x = pack_bf2(acc[m][n][0], acc[m][n][1]); w.y = pack_bf2(acc[m][n][2], acc[m][n][3]); *(uint2*)(dst + (size_t)(row + 16 * m) * ld + c0 + 16 * n) = w; }
        }
    }
};
struct EpiOutProj {
    const P& p;
    __device__ __forceinline__ void operator()(const f32x4 (&acc)[4][4], int row, int col) const {
#pragma unroll
        for (int m = 0; m < 4; ++m) {
            float s1 = 0.f, s2 = 0.f;
#pragma unroll
            for (int n = 0; n < 4; ++n) {
                const size_t o = (size_t)(row + 16 * m) * 1024 + col + 16 * n;
                const f32x4 y = *(const f32x4*)(p.x + o) * ALPHA + acc[m][n];
                s1 += (y[0] + y[1]) + (y[2] + y[3]); s2 += (y[0] * y[0] + y[1] * y[1]) + (y[2] * y[2] + y[3] * y[3]);
                u32x2 w; w.x = pack_bf2(y[0], y[1]); w.y = pack_bf2(y[2], y[3]);
                *(u32x2*)(WS(bf16, OFF_Y1B) + o) = w;
            }
            s1 += __shfl_xor(s1, 16); s1 += __shfl_xor(s1, 32); s2 += __shfl_xor(s2, 16); s2 += __shfl_xor(s2, 32);
            if ((tidx() & 63u) < 16u) { atomicAdd(WS(float, OFF_STAT1) + (size_t)(row + 16 * m) * 2, s1); atomicAdd(WS(float, OFF_STAT1) + (size_t)(row + 16 * m) * 2 + 1, s2); }
        }
    }
};
struct EpiPeerQ {
    const P& p;
    __device__ __forceinline__ void operator()(const f32x4 (&acc)[4][4], int row, int col) const {
        f32x4 cs[4], bq[4];
#pragma unroll
        for (int n = 0; n < 4; ++n) { cs[n] = *(const f32x4*)(WS(float, OFF_COLSUM) + col + 16 * n); bq[n] = *(const f32x4*)(WS(float, OFF_BIASQ) + col + 16 * n); }
#pragma unroll
        for (int m = 0; m < 4; ++m) {
            const f32x2 st = *(const f32x2*)(WS(float, OFF_STAT1) + (size_t)(row + 16 * m) * 2);
            const float mu = st.x * (1.0f / 1024.0f), rs = rsqrtf(fmaxf(st.y * (1.0f / 1024.0f) - mu * mu, 0.f) + 1e-5f);
#pragma unroll
            for (int n = 0; n < 4; ++n) {
                const f32x4 q = (acc[m][n] - cs[n] * mu) * rs + bq[n];
                u32x2 w; w.x = pack_bf2(q[0], q[1]); w.y = pack_bf2(q[2], q[3]);
                *(u32x2*)(WS(bf16, OFF_PQ) + (size_t)(row + 16 * m) * 2048 + col + 16 * n) = w;
            }
        }
    }
};
__device__ __forceinline__ void ph_inproj(const P& p, unsigned char* lds) {
    const EpiInProj epi{p};
    for (unsigned t = VBID; t < 256u * 24u; t += VGRID) { int pm, pn, npm = -1, npn = 0; gemm_tile_coord(t, 24, pm, pn); if (t + VGRID < 256u * 24u) gemm_tile_coord(t + VGRID, 24, npm, npn); gemm_tile<false>(WS(bf16, OFF_R1), WS(bf16, OFF_WINT), 1024, pm * 128, pn * 128, lds, nullptr, epi, t == VBID, npm * 128, npn * 128); }
}
__device__ __forceinline__ void ph_outproj(const P& p, unsigned char* lds) {
    const EpiOutProj epi{p};
    for (unsigned t = VBID; t < 256u * 8u; t += VGRID) { int pm, pn, npm = -1, npn = 0; gemm_tile_coord(t, 8, pm, pn); if (t + VGRID < 256u * 8u) gemm_tile_coord(t + VGRID, 8, npm, npn); gemm_tile<true>(WS(bf16, OFF_R1), WS(bf16, OFF_WOUTT), 1024, pm * 128, pn * 128, lds, WS(float, OFF_SSQ), epi, t == VBID, npm * 128, npn * 128); }
}
__device__ __forceinline__ void ph_peerq(const P& p, unsigned char* lds) {
    const EpiPeerQ epi{p};
    for (unsigned t = VBID; t < 256u * 16u; t += VGRID) { int pm, pn, npm = -1, npn = 0; gemm_tile_coord(t, 16, pm, pn); if (t + VGRID < 256u * 16u) gemm_tile_coord(t + VGRID, 16, npm, npn); gemm_tile<false>(WS(bf16, OFF_Y1B), WS(bf16, OFF_WQT), 1024, pm * 128, pn * 128, lds, nullptr, epi, t == VBID, npm * 128, npn * 128); }
}


namespace pg8 {
#define PG8_LAS __attribute__((address_space(3)))
typedef unsigned short bf16_t;
constexpr int BM = 256, BK = 64, HALF = 128, HTB = HALF * BK * 2  , STAGE_BYTES = 8 * HTB, NXCD = 8, WGM = 8;

__host__ __device__ __forceinline__ int lds_byte(int r, int c) { const int st = (r >> 4) * 2 + (c >> 5), rr = r & 15, cc = c & 31, ob = rr * 64 + cc * 2; return st * 1024 + (ob ^ (((ob >> 9) & 1) << 5)); }
__host__ __device__ __forceinline__ void stage_rc(int b, int& R, int& C) { const int st = b / 1024, sb = b % 1024, swz = sb ^ (((sb >> 9) & 1) << 5); R = (st >> 1) * 16 + swz / 64; C = (st & 1) * 32 + (swz % 64) / 2; }
__host__ __device__ __forceinline__ int perm32(int rho) { const int n = rho >> 4, i = rho & 15; return 8 * (i >> 2) + 4 * n + (i & 3); }

struct Unit { int pm, pn; };
struct Gemm { const bf16_t* A; const bf16_t* Bt; int M, N, K; };

struct StaticOrder {
    int nM, nN, nwg, G, c;
    __host__ __device__ void init(int M, int N, int G_, int c_) { nM = M / BM; nN = N / BM; nwg = nM * nN; G = G_; c = c_; }
    __host__ __device__ bool next(int i, Unit& u) const {
        const long L = (long)i * G + c; if (L >= nwg) return false;
        int wgid = (int)L; { const int q = nwg / NXCD, r = nwg % NXCD, xcd = wgid % NXCD, off = wgid / NXCD; wgid = (xcd < r ? xcd * (q + 1) : r * (q + 1) + (xcd - r) * q) + off; }
        const int nig = WGM * nN, gid = wgid / nig, fm = gid * WGM, gsz = (nM - fm) < WGM ? (nM - fm) : WGM;
        u.pm = fm + ((wgid % nig) % gsz); u.pn = (wgid % nig) / gsz; return true;
    }
    __device__ __forceinline__ void a_ready(const Unit&) const {}
    __device__ __forceinline__ void done(const Unit&) const {}
};
template <class Epi, class Sched>
__device__ __forceinline__ void gemm_phase(PG8_LAS unsigned char* lds, const Gemm g, const Sched& S, const Epi& E) {
    const int tid = threadIdx.x, wid = __builtin_amdgcn_readfirstlane(tid >> 6), lane = tid & 63, wr = wid >> 2, wc = wid & 3, fr = lane & 15, fq = lane >> 4;
    const int K = g.K, nt = K / BK;
    unsigned voffA[2], voffB[2];
#pragma unroll
    for (int i = 0; i < 2; ++i) { int R, C; stage_rc(tid * 16 + i * 8192, R, C); const int Rb = Epi::PERM ? ((R & ~31) + perm32(R & 31)) : R;
        voffA[i] = (unsigned)(R * K + C) * 2u; voffB[i] = (unsigned)(Rb * K + C) * 2u; }
    const size_t kstep = (size_t)(BK * 2);
    const size_t hstep = (size_t)HALF * K * 2;
    const size_t tstep = 2 * hstep;
    const unsigned ldsw = (unsigned)wid * 1024u;
    const int aoff = lds_byte(wr * 64 + fr, fq * 8), boff = lds_byte(wc * 32 + fr, fq * 8);
#define PG8_SA(b, h) (((b) * 2 + (h)) * HTB)
#define PG8_SB(b, h) ((4 + (b) * 2 + (h)) * HTB)
#define PG8_STAGE(bufoff, gbase, voff) do { _Pragma("unroll") for (int _i = 0; _i < 2; ++_i) \
        __builtin_amdgcn_global_load_lds((const unsigned*)((const char*)(gbase) + (voff)[_i]), (PG8_LAS unsigned*)(lds + (bufoff) + ldsw + _i * 8192), 16, 0, 0); } while (0)
#define PG8_LDA(dst, b, h) do { _Pragma("unroll") for (int m = 0; m < 4; ++m) _Pragma("unroll") for (int k = 0; k < 2; ++k) dst[m][k] = *(const PG8_LAS bf16x8*)(lds + PG8_SA(b, h) + aoff + m * 2048 + k * 1024); } while (0)
#define PG8_LDB(dst, b, h) do { _Pragma("unroll") for (int n = 0; n < 2; ++n) _Pragma("unroll") for (int k = 0; k < 2; ++k) dst[n][k] = *(const PG8_LAS bf16x8*)(lds + PG8_SB(b, h) + boff + n * 2048 + k * 1024); } while (0)
#define PG8_MMA(ai, bj, At, Bt) do { __builtin_amdgcn_s_setprio(1); _Pragma("unroll") for (int m = 0; m < 4; ++m) _Pragma("unroll") for (int n = 0; n < 2; ++n) _Pragma("unroll") for (int k = 0; k < 2; ++k) \
        acc[ai][bj][m][n] = __builtin_amdgcn_mfma_f32_16x16x32_bf16(Bt[n][k], At[m][k], acc[ai][bj][m][n], 0, 0, 0); __builtin_amdgcn_s_setprio(0); } while (0)
#define PG8_WAIT_V(n) asm volatile("s_waitcnt vmcnt(" #n ")" ::: "memory")
#define PG8_WAIT_L(n) asm volatile("s_waitcnt lgkmcnt(" #n ")" ::: "memory")
#define PG8_BAR __builtin_amdgcn_s_barrier()
#define PG8_SCHED __builtin_amdgcn_sched_barrier(0)
    Unit cur, nxt; int ui = 0;
    if (!S.next(0, cur)) return;
    f32x4 acc[2][2][4][2];
#pragma unroll
    for (int a = 0; a < 2; ++a)
#pragma unroll
        for (int b = 0; b < 2; ++b)
#pragma unroll
            for (int m = 0; m < 4; ++m)
#pragma unroll
                for (int n = 0; n < 2; ++n) acc[a][b][m][n] = (f32x4){0.f, 0.f, 0.f, 0.f};
    bf16x8 At[4][2], B0[2][2], B1[2][2];
    const char* cA = (const char*)g.A + (size_t)cur.pm * tstep; const char* cB = (const char*)g.Bt + (size_t)cur.pn * tstep;
    S.a_ready(cur);
    PG8_STAGE(PG8_SB(0, 0), cB, voffB); PG8_STAGE(PG8_SA(0, 0), cA, voffA); PG8_STAGE(PG8_SB(0, 1), cB + hstep, voffB); PG8_STAGE(PG8_SA(0, 1), cA + hstep, voffA);
    if (wr == 1) PG8_BAR;
    PG8_WAIT_V(4); PG8_BAR;
    PG8_STAGE(PG8_SB(1, 0), cB + kstep, voffB); PG8_STAGE(PG8_SA(1, 0), cA + kstep, voffA); PG8_STAGE(PG8_SB(1, 1), cB + hstep + kstep, voffB);
    PG8_WAIT_V(6); PG8_BAR;
    for (;;) {
        const bool has_next = S.next(ui + 1, nxt);
        const char* nA = has_next ? (const char*)g.A + (size_t)nxt.pm * tstep : cA; const char* nB = has_next ? (const char*)g.Bt + (size_t)nxt.pn * tstep : cB;
        for (int t = 0; t < nt; t += 2) {
            const bool last = (t == nt - 2);
            const char* a1 = cA + (size_t)(t + 1) * kstep;
            const char* a2 = last ? nA : cA + (size_t)(t + 2) * kstep; const char* b2 = last ? nB : cB + (size_t)(t + 2) * kstep;
            const char* a3 = a2 + kstep; const char* b3 = b2 + kstep;
            if (last && has_next) S.a_ready(nxt);
            PG8_LDB(B0, 0, 0); PG8_SCHED; PG8_LDA(At, 0, 0); PG8_STAGE(PG8_SA(1, 1), a1 + hstep, voffA);
            PG8_WAIT_L(8); PG8_BAR; PG8_WAIT_L(0); PG8_MMA(0, 0, At, B0); PG8_BAR; PG8_SCHED;
            PG8_LDB(B1, 0, 1); PG8_STAGE(PG8_SB(0, 0), b2, voffB);
            PG8_BAR; PG8_WAIT_L(0); PG8_MMA(0, 1, At, B1); PG8_BAR;
            PG8_LDA(At, 0, 1); PG8_STAGE(PG8_SA(0, 0), a2, voffA);
            PG8_BAR; PG8_WAIT_L(0); PG8_MMA(1, 0, At, B0); PG8_BAR; PG8_SCHED;
            PG8_STAGE(PG8_SB(0, 1), b2 + hstep, voffB);
            PG8_WAIT_V(6); PG8_BAR; PG8_MMA(1, 1, At, B1); PG8_BAR;
            PG8_LDB(B0, 1, 0); PG8_SCHED; PG8_LDA(At, 1, 0); PG8_STAGE(PG8_SA(0, 1), a2 + hstep, voffA);
            PG8_WAIT_L(8); PG8_BAR; PG8_WAIT_L(0); PG8_MMA(0, 0, At, B0); PG8_BAR; PG8_SCHED;
            PG8_LDB(B1, 1, 1); PG8_STAGE(PG8_SB(1, 0), b3, voffB);
            PG8_BAR; PG8_WAIT_L(0); PG8_MMA(0, 1, At, B1); PG8_BAR;
            PG8_LDA(At, 1, 1); PG8_STAGE(PG8_SA(1, 0), a3, voffA);
            PG8_BAR; PG8_WAIT_L(0); PG8_MMA(1, 0, At, B0); PG8_BAR; PG8_SCHED;
            PG8_STAGE(PG8_SB(1, 1), b3 + hstep, voffB);
            PG8_WAIT_V(6); PG8_BAR; PG8_MMA(1, 1, At, B1); PG8_BAR;
        }
        if constexpr (!Epi::AFTER_DRAIN) { E(acc, cur, wr, wc, fr, fq); S.done(cur); }
        if (!has_next) break;
#pragma unroll
        for (int a = 0; a < 2; ++a)
#pragma unroll
            for (int b = 0; b < 2; ++b)
#pragma unroll
                for (int m = 0; m < 4; ++m)
#pragma unroll
                    for (int n = 0; n < 2; ++n) acc[a][b][m][n] = (f32x4){0.f, 0.f, 0.f, 0.f};
        cur = nxt; cA = nA; cB = nB; ++ui;
    }
    PG8_WAIT_V(0);
    if (wr == 0) PG8_BAR;
    PG8_BAR;
    if constexpr (Epi::AFTER_DRAIN) { E.fused(acc, cur, wr, wc, fr, fq, lds, wid, lane); S.done(cur); }
#undef PG8_SA
#undef PG8_SB
#undef PG8_STAGE
#undef PG8_LDA
#undef PG8_LDB
#undef PG8_MMA
#undef PG8_WAIT_V
#undef PG8_WAIT_L
#undef PG8_BAR
#undef PG8_SCHED
}
}

struct EpiInProj8 {
    static constexpr bool PERM = false, AFTER_DRAIN = false;
    const P& p;
    __device__ __forceinline__ void operator()(const f32x4 (&acc)[2][2][4][2], const pg8::Unit& u, int wr, int wc, int fr, int fq) const {
        const int colt = u.pn * 256;
        if (colt < 1024) {
            const bool isq = colt < 512;
            bf16* dst = WS(bf16, isq ? OFF_QR : OFF_KR);
            const float qs = isq ? 0.125f * 1.4426950408889634f : 1.0f;
            const int i0 = 16 * (wc & 1) + 4 * fq;
#pragma unroll
            for (int ai = 0; ai < 2; ++ai)
#pragma unroll
                for (int m = 0; m < 4; ++m) {
                    const size_t tok = (size_t)u.pm * 256 + ai * 128 + wr * 64 + m * 16 + fr;
                    const f32x4 cs = *(const f32x4*)(WS(float, OFF_ROPEC) + tok * 32 + i0), sn = *(const f32x4*)(WS(float, OFF_ROPES) + tok * 32 + i0);
#pragma unroll
                    for (int bj = 0; bj < 2; ++bj) {
                        const int hb = ((colt + bj * 128 + 32 * wc) & 511) & ~63;
                        const f32x4 x1 = acc[ai][bj][m][0], x2 = acc[ai][bj][m][1];
                        const f32x4 o1 = (x1 * cs - x2 * sn) * qs, o2 = (x2 * cs + x1 * sn) * qs;
                        u32x2 w1, w2; w1.x = pack_bf2(o1[0], o1[1]); w1.y = pack_bf2(o1[2], o1[3]); w2.x = pack_bf2(o2[0], o2[1]); w2.y = pack_bf2(o2[2], o2[3]);
                        *(u32x2*)(dst + tok * 512 + hb + i0) = w1; *(u32x2*)(dst + tok * 512 + hb + i0 + 32) = w2;
                    }
                }
        } else if (colt < 1536) {
#pragma unroll
            for (int ai = 0; ai < 2; ++ai)
#pragma unroll
                for (int m = 0; m < 4; ++m) {
                    const int tok = u.pm * 256 + ai * 128 + wr * 64 + m * 16 + fr, b = tok >> 11, s = tok & 2047;
#pragma unroll
                    for (int bj = 0; bj < 2; ++bj)
#pragma unroll
                        for (int n = 0; n < 2; ++n)
#pragma unroll
                            for (int j = 0; j < 4; ++j) { const int c = colt - 1024 + bj * 128 + 32 * wc + 16 * n + 4 * fq + j; WS(bf16, OFF_VTT)[((size_t)b * 512 + c) * SEQ + s] = f2bf(acc[ai][bj][m][n][j]); }
                }
        } else {
            bf16* dst; int ld, c0;
            if (colt < 2048) { dst = WS(bf16, OFF_Z); ld = 512; c0 = colt - 1536; } else { dst = WS(bf16, OFF_XBC); ld = 1024; c0 = colt - 2048; }
#pragma unroll
            for (int ai = 0; ai < 2; ++ai)
#pragma unroll
                for (int m = 0; m < 4; ++m) {
                    const size_t tok = (size_t)u.pm * 256 + ai * 128 + wr * 64 + m * 16 + fr;
#pragma unroll
                    for (int bj = 0; bj < 2; ++bj)
#pragma unroll
                        for (int n = 0; n < 2; ++n) { u32x2 w; w.x = pack_bf2(acc[ai][bj][m][n][0], acc[ai][bj][m][n][1]); w.y = pack_bf2(acc[ai][bj][m][n][2], acc[ai][bj][m][n][3]);
                            *(u32x2*)(dst + tok * ld + c0 + bj * 128 + 32 * wc + 16 * n + 4 * fq) = w; }
                }
        }
    }
};
struct EpiPeerQ8 {
    static constexpr bool PERM = false, AFTER_DRAIN = false;
    const P& p;
    __device__ __forceinline__ void operator()(const f32x4 (&acc)[2][2][4][2], const pg8::Unit& u, int wr, int wc, int fr, int fq) const {
        const int col0 = u.pn * 256 + 32 * wc + 4 * fq;
        f32x4 cs[2][2], bq[2][2];
#pragma unroll
        for (int bj = 0; bj < 2; ++bj)
#pragma unroll
            for (int n = 0; n < 2; ++n) { cs[bj][n] = *(const f32x4*)(WS(float, OFF_COLSUM) + col0 + bj * 128 + 16 * n); bq[bj][n] = *(const f32x4*)(WS(float, OFF_BIASQ) + col0 + bj * 128 + 16 * n); }
#pragma unroll
        for (int ai = 0; ai < 2; ++ai)
#pragma unroll
            for (int m = 0; m < 4; ++m) {
                const size_t tok = (size_t)u.pm * 256 + ai * 128 + wr * 64 + m * 16 + fr;
                const f32x2 st = *(const f32x2*)(WS(float, OFF_STAT1) + tok * 2);
                const float mu = st.x * (1.0f / 1024.0f), rs = rsqrtf(fmaxf(st.y * (1.0f / 1024.0f) - mu * mu, 0.f) + 1e-5f);
#pragma unroll
                for (int bj = 0; bj < 2; ++bj)
#pragma unroll
                    for (int n = 0; n < 2; ++n) {
                        const f32x4 q = (acc[ai][bj][m][n] - cs[bj][n] * mu) * rs + bq[bj][n];
                        u32x2 w; w.x = pack_bf2(q[0], q[1]); w.y = pack_bf2(q[2], q[3]);
                        *(u32x2*)(WS(bf16, OFF_PQ) + tok * 2048 + col0 + bj * 128 + 16 * n) = w;
                    }
            }
    }
};
__device__ __forceinline__ float quad_max(float v) {
    const auto r = __builtin_amdgcn_permlane16_swap(__float_as_uint(v), __float_as_uint(v), false, false);
    v = fmaxf(__uint_as_float(r[0]), __uint_as_float(r[1]));
    const auto q = __builtin_amdgcn_permlane32_swap(__float_as_uint(v), __float_as_uint(v), false, false);
    return fmaxf(__uint_as_float(q[0]), __uint_as_float(q[1]));
}
__device__ __forceinline__ float quad_sum(float v) {
    const auto r = __builtin_amdgcn_permlane16_swap(__float_as_uint(v), __float_as_uint(v), false, false);
    v = __uint_as_float(r[0]) + __uint_as_float(r[1]);
    const auto q = __builtin_amdgcn_permlane32_swap(__float_as_uint(v), __float_as_uint(v), false, false);
    return __uint_as_float(q[0]) + __uint_as_float(q[1]);
}

__device__ __forceinline__ void ph_ssd_finalize(const P& p) {
    const int tid = tidx(), wid = tid >> 6, lane = tid & 63;
    for (unsigned tb = (VBID * 4 + wid) * 4; tb < (unsigned)NT; tb += VGRID * 16) {
        f32x2 sq[4]; u32x4 v[4];
#pragma unroll
        for (int q = 0; q < 4; ++q) { sq[q] = *(const f32x2*)(WS(float, OFF_SSQ) + (size_t)(tb + q) * 2); v[q] = *(const u32x4*)(WS(bf16, OFF_R1) + (size_t)(tb + q) * 1024 + 512 + lane * 8); }
#pragma unroll
        for (int q = 0; q < 4; ++q) {
            const float r = rsqrtf((lane < 32 ? sq[q].x : sq[q].y) * (1.0f / 256.0f) + 1e-5f);
            u32x4 o;
#pragma unroll
            for (int k = 0; k < 4; ++k) o[k] = pack_bf2(__uint_as_float(v[q][k] << 16) * r, __uint_as_float(v[q][k] & 0xFFFF0000u) * r);
            *(u32x4*)(WS(bf16, OFF_R1) + (size_t)(tb + q) * 1024 + 512 + lane * 8) = o;
        }
    }
}
struct EpiOutProj8 {
    static constexpr bool PERM = false, AFTER_DRAIN = false;
    const P& p;
    __device__ __forceinline__ void operator()(const f32x4 (&acc)[2][2][4][2], const pg8::Unit& u, int wr, int wc, int fr, int fq) const {
        const int col0 = u.pn * 256 + 32 * wc + 4 * fq;
#pragma unroll
        for (int ai = 0; ai < 2; ++ai)
#pragma unroll
            for (int m = 0; m < 4; ++m) {
                const size_t tok = (size_t)u.pm * 256 + ai * 128 + wr * 64 + m * 16 + fr;
                float s1 = 0.f, s2 = 0.f;
#pragma unroll
                for (int bj = 0; bj < 2; ++bj)
#pragma unroll
                    for (int n = 0; n < 2; ++n) {
                        const size_t o = tok * 1024 + col0 + bj * 128 + 16 * n;
                        const f32x4 y = *(const f32x4*)(p.x + o) * ALPHA + acc[ai][bj][m][n];
                        s1 += (y[0] + y[1]) + (y[2] + y[3]); s2 += (y[0] * y[0] + y[1] * y[1]) + (y[2] * y[2] + y[3] * y[3]);
                        u32x2 w; w.x = pack_bf2(y[0], y[1]); w.y = pack_bf2(y[2], y[3]);
                        *(u32x2*)(WS(bf16, OFF_Y1B) + o) = w;
                    }
                s1 = quad_sum(s1); s2 = quad_sum(s2);
                if (fq == 0) { atomicAdd(WS(float, OFF_STAT1) + tok * 2, s1); atomicAdd(WS(float, OFF_STAT1) + tok * 2 + 1, s2); }
            }
    }
};
__device__ __forceinline__ void ph_outproj8(const P& p) {
    const pg8::Gemm g{WS(bf16, OFF_R1), WS(bf16, OFF_WOUTT), NT, 1024, 1024};
    pg8::StaticOrder S; S.init(NT, 1024, (int)gridDim.x, (int)blockIdx.x);
    const EpiOutProj8 E{p};
    pg8::gemm_phase((PG8_LAS unsigned char*)g_smem, g, S, E);
}

__device__ __forceinline__ void ph_inproj8(const P& p) {
    const pg8::Gemm g{WS(bf16, OFF_R1), WS(bf16, OFF_WINT), NT, 3072, 1024};
    pg8::StaticOrder S; S.init(NT, 3072, (int)gridDim.x, (int)blockIdx.x);
    const EpiInProj8 E{p};
    pg8::gemm_phase((PG8_LAS unsigned char*)g_smem, g, S, E);
}
__device__ __forceinline__ void ph_peerq8(const P& p) {
    const pg8::Gemm g{WS(bf16, OFF_Y1B), WS(bf16, OFF_WQT), NT, 2048, 1024};
    pg8::StaticOrder S; S.init(NT, 2048, (int)gridDim.x, (int)blockIdx.x);
    const EpiPeerQ8 E{p};
    pg8::gemm_phase((PG8_LAS unsigned char*)g_smem, g, S, E);
}

__device__ __forceinline__ unsigned queue_next(unsigned* ctr, volatile unsigned* slot) {
    half_sync();
    if (tidx() == 0) *slot = atomicAdd(ctr, 1u);
    half_sync();
    return *slot;
}
typedef float f32x16 __attribute__((ext_vector_type(16)));
typedef __bf16 bf2_t __attribute__((ext_vector_type(2)));
__device__ __forceinline__ void ce_desc(float& a, float& b) {
    float hi, lo;
    asm("v_max_f32 %0, %1, %2" : "=v"(hi) : "v"(a), "v"(b));
    asm("v_min_f32 %0, %1, %2" : "=v"(lo) : "v"(a), "v"(b));
    a = hi; b = lo;
}
__device__ __forceinline__ void sort16_desc(float (&v)[16]) {
#pragma unroll
    for (int k = 2; k <= 16; k <<= 1)
#pragma unroll
        for (int j = k >> 1; j > 0; j >>= 1)
#pragma unroll
            for (int i = 0; i < 16; ++i) { const int l = i ^ j; if (l > i) { if ((i & k) == 0) ce_desc(v[i], v[l]); else ce_desc(v[l], v[i]); } }
}
__device__ __forceinline__ void merge16_desc(float (&x)[16], const float (&y)[16]) {
#pragma unroll
    for (int i = 0; i < 16; ++i) { float m; asm("v_max_f32 %0, %1, %2" : "=v"(m) : "v"(x[i]), "v"(y[15 - i])); x[i] = m; }
#pragma unroll
    for (int j = 8; j > 0; j >>= 1)
#pragma unroll
        for (int i = 0; i < 16; ++i) { const int l = i ^ j; if (l > i) ce_desc(x[i], x[l]); }
}
__device__ __forceinline__ void top16_of_64(const float (&v)[64], float (&out)[16]) {
#pragma unroll
    for (int i = 0; i < 16; ++i) out[i] = v[i];
    sort16_desc(out);
#pragma unroll
    for (int g = 1; g < 4; ++g) {
        float t[16];
#pragma unroll
        for (int i = 0; i < 16; ++i) t[i] = v[16 * g + i];
        sort16_desc(t);
        merge16_desc(out, t);
    }
}
struct CandTab { int i[64], j[64]; };
constexpr CandTab make_cand() {
    CandTab t{}; int n = 0;
    for (int i = 0; i < 16; ++i) for (int j = 0; j < 16; ++j) if ((i + 1) * (j + 1) <= 16) { t.i[n] = i; t.j[n] = j; ++n; }
    for (; n < 64; ++n) { t.i[n] = -1; t.j[n] = -1; }
    return t;
}
__device__ __forceinline__ float gelu_erf(float x) { return 0.5f * x * (1.0f + erff(x * 0.70710678118654752f)); }

__device__ __forceinline__ void peer_route_unit(const P& p, unsigned unit, unsigned char* lds) {
    const int tid = tidx(), wid = tid >> 6, lane = tid & 63, t = lane & 31, half = lane >> 5;
    float* RES = (float*)lds + wid * 2048;
    unsigned short* IDS = (unsigned short*)(lds + 32768);
    float* GATE = (float*)(lds + 40960);
    const int tok0 = (int)unit * 32;
    for (int hcl = 0; hcl < 4; ++hcl) {
        const int hl = hcl >> 1, c = hcl & 1, hc = (2 * wid + hl) * 2 + c;
        const bf16* kb = WS(bf16, OFF_KEYS) + ((size_t)hc * 128 + t) * 128 + 8 * half;
        const bf16* qb = WS(bf16, OFF_PQ) + (size_t)(tok0 + t) * 2048 + hc * 128 + 8 * half;
        bf16x8 qf[8], kf[3][8];
#pragma unroll
        for (int ks = 0; ks < 8; ++ks) qf[ks] = *(const bf16x8*)(qb + ks * 16);
#pragma unroll
        for (int ks = 0; ks < 8; ++ks) kf[0][ks] = *(const bf16x8*)(kb + ks * 16);
#pragma unroll
        for (int ks = 0; ks < 8; ++ks) kf[1][ks] = *(const bf16x8*)(kb + (size_t)32 * 128 + ks * 16);
        f32x16 acc[4];
#pragma unroll
        for (int nt = 0; nt < 4; ++nt) {
            if (nt + 2 < 4) {
#pragma unroll
                for (int ks = 0; ks < 8; ++ks) kf[(nt + 2) % 3][ks] = *(const bf16x8*)(kb + (size_t)(nt + 2) * 32 * 128 + ks * 16);
            }
            __builtin_amdgcn_sched_barrier(0);
            acc[nt] = (f32x16){0.f, 0.f, 0.f, 0.f, 0.f, 0.f, 0.f, 0.f, 0.f, 0.f, 0.f, 0.f, 0.f, 0.f, 0.f, 0.f};
#pragma unroll
            for (int ks = 0; ks < 8; ++ks) acc[nt] = __builtin_amdgcn_mfma_f32_32x32x16_bf16(kf[nt % 3][ks], qf[ks], acc[nt], 0, 0, 0);
            __builtin_amdgcn_sched_barrier(0);
        }
        float v[64];
#pragma unroll
        for (int nt = 0; nt < 4; ++nt)
#pragma unroll
            for (int r = 0; r < 16; ++r) { const unsigned n = (unsigned)(nt * 32 + (r & 3) + 8 * (r >> 2)); v[nt * 16 + r] = __uint_as_float((__float_as_uint(acc[nt][r]) & 0xFFFFFF80u) | n); }
        float top[16];
        top16_of_64(v, top);
        float oth[16];
#pragma unroll
        for (int i = 0; i < 16; ++i) { top[i] = __uint_as_float(__float_as_uint(top[i]) | (unsigned)(half << 2)); oth[i] = __shfl_xor(top[i], 32); }
        merge16_desc(top, oth);
        if (half == 0) {
#pragma unroll
            for (int i = 0; i < 16; ++i) RES[((hl * 2 + c) * 16 + i) * 32 + t] = top[i];
        }
    }
    __builtin_amdgcn_s_waitcnt(0xC07F);
    {
        float a[16], b[16];
#pragma unroll
        for (int i = 0; i < 16; ++i) { a[i] = RES[((half * 2 + 0) * 16 + i) * 32 + t]; b[i] = RES[((half * 2 + 1) * 16 + i) * 32 + t]; }
        constexpr CandTab CT = make_cand();
        float v[64];
#pragma unroll
        for (int n = 0; n < 64; ++n) {
            if (CT.i[n] >= 0) v[n] = __uint_as_float((__float_as_uint(a[CT.i[n] < 0 ? 0 : CT.i[n]] + b[CT.j[n] < 0 ? 0 : CT.j[n]]) & 0xFFFFFF00u) | (unsigned)(CT.i[n] * 16 + CT.j[n]));
            else v[n] = __uint_as_float(0xFF800000u);
        }
        float top[16];
        top16_of_64(v, top);
        float e[16], sum = 0.f;
#pragma unroll
        for (int i = 0; i < 16; ++i) { e[i] = __expf(top[i] - top[0]); sum += e[i]; }
        const float inv = 1.0f / sum;
        const int head = 2 * wid + half;
#pragma unroll
        for (int i = 0; i < 16; ++i) {
            const unsigned code = __float_as_uint(top[i]) & 0xFFu;
            const unsigned ia = __float_as_uint(RES[((half * 2 + 0) * 16 + (code >> 4)) * 32 + t]) & 0x7Fu;
            const unsigned ib = __float_as_uint(RES[((half * 2 + 1) * 16 + (code & 15u)) * 32 + t]) & 0x7Fu;
            IDS[t * 128 + head * 16 + i] = (unsigned short)(ia * 128u + ib);
            GATE[t * 128 + head * 16 + i] = e[i] * inv;
        }
    }
    half_sync();
#pragma unroll
    for (int it = 0; it < 16; ++it) {
        const int item = it * 256 + tid, tl = item >> 7, j = item & 127, k = 8 * (j & 15) + (j >> 4);
        WS(unsigned short, OFF_IDSP)[(size_t)(tok0 + tl) * 128 + j] = IDS[tl * 128 + k];
        WS(float, OFF_GATEP)[(size_t)(tok0 + tl) * 128 + j] = GATE[tl * 128 + k];
    }
    {
        u32x4 hA[8], hB[8];
#pragma unroll
        for (int ti = 0; ti < 8; ++ti) { const bf16* yrow = WS(bf16, OFF_Y1B) + ((size_t)tok0 + wid * 8 + ti) * 1024 + lane * 16; hA[ti] = *(const u32x4*)yrow; hB[ti] = *(const u32x4*)(yrow + 8); }
        float gg[16], bb[16];
#pragma unroll
        for (int q4 = 0; q4 < 4; ++q4) { const f32x4 gv = *(const f32x4*)(p.ln1_g + lane * 16 + 4 * q4), bv = *(const f32x4*)(p.ln1_b + lane * 16 + 4 * q4);
#pragma unroll
            for (int e = 0; e < 4; ++e) { gg[4 * q4 + e] = gv[e]; bb[4 * q4 + e] = bv[e]; } }
#pragma unroll
        for (int ti = 0; ti < 8; ++ti) {
            const size_t tok = (size_t)tok0 + wid * 8 + ti;
            const f32x2 st = *(const f32x2*)(WS(float, OFF_STAT1) + tok * 2);
            const float mu = st.x * (1.0f / 1024.0f), rs = rsqrtf(fmaxf(st.y * (1.0f / 1024.0f) - mu * mu, 0.f) + 1e-5f);
            float hf[16];
#pragma unroll
            for (int k = 0; k < 4; ++k) { hf[2 * k] = __uint_as_float(hA[ti][k] << 16); hf[2 * k + 1] = __uint_as_float(hA[ti][k] & 0xFFFF0000u); hf[8 + 2 * k] = __uint_as_float(hB[ti][k] << 16); hf[9 + 2 * k] = __uint_as_float(hB[ti][k] & 0xFFFF0000u); }
#pragma unroll
            for (int k = 0; k < 16; ++k) hf[k] = (hf[k] - mu) * rs * gg[k] + bb[k];
            u32x4 o0, o1;
#pragma unroll
            for (int k = 0; k < 4; ++k) { o0[k] = pack_bf2(hf[2 * k], hf[2 * k + 1]); o1[k] = pack_bf2(hf[8 + 2 * k], hf[9 + 2 * k]); }
            bf16* hrow = WS(bf16, OFF_R1) + tok * 1024 + lane * 16;
            *(u32x4*)hrow = o0; *(u32x4*)(hrow + 8) = o1;
            float am = 0.f;
#pragma unroll
            for (int k = 0; k < 16; ++k) am = fmaxf(am, fabsf(hf[k]));
            am = wave_max(am);
            const float hinv = am > 0.f ? 127.0f / am : 0.f;
            u32x4 hq;
#pragma unroll
            for (int i = 0; i < 4; ++i) { unsigned a4 = 0u;
#pragma unroll
                for (int e = 0; e < 4; ++e) a4 |= ((unsigned)(int)rintf(hf[4 * i + e] * hinv) & 0xFFu) << (8 * e);
                hq[i] = a4; }
            *(u32x4*)(p.ws + OFF_HQ + tok * 1024 + lane * 16) = hq;
            if (lane == 0) WS(float, OFF_HSC)[tok] = am * (1.0f / 127.0f);
            if (lane < 2) WS(float, OFF_STAT)[tok * 2 + lane] = 0.f;
        }
    }
    half_sync();
}

template <class F>
__device__ __forceinline__ void sliced_units(unsigned* q  , unsigned xcc, volatile unsigned* slot, F f) {
    for (unsigned off = 0; off < 8u; ++off) {
        const unsigned s = (xcc + off) & 7u;
        for (;;) {
            const unsigned t = queue_next(q + 64 * s, slot);
            if (t >= (unsigned)(NT / 32)) break;
            f(t, s);
        }
    }
}
__device__ __forceinline__ void peer_u_unit(const P& p, unsigned tile, unsigned s, unsigned char* lds) {
    const int tid = tidx(), wid = tid >> 6, lane = tid & 63, g = lane >> 3, cg = lane & 7;
    const unsigned char* ub = p.ws + OFF_UQ + s * 128 + cg * 16;
    const size_t tokw = (size_t)tile * 32 + wid * 8;
    const unsigned short* idp = WS(unsigned short, OFF_IDSP) + tokw * 128 + g * 16;
    const unsigned char* hqp = p.ws + OFF_HQ + tokw * 1024 + s * 128 + cg * 16;
    u32x4 idv[2][2], hq[2], rows[2][16];
    idv[0][0] = *(const u32x4*)idp; idv[0][1] = *(const u32x4*)(idp + 8);
    idv[1][0] = *(const u32x4*)(idp + 128); idv[1][1] = *(const u32x4*)(idp + 136);
#define PEER_ISSUE_ROWS(BUF, TI, BASE)                                                                                   \
    { _Pragma("unroll") for (int i = 0; i < 16; ++i) {                                                                   \
          const unsigned w_ = i < 8 ? idv[BUF][0][i >> 1] : idv[BUF][1][(i - 8) >> 1];                                    \
          const unsigned id_ = (i & 1) ? (w_ >> 16) : (w_ & 0xFFFFu);                                                    \
          rows[BUF][i] = *(const u32x4*)((BASE) + (size_t)id_ * 1024); } }
    PEER_ISSUE_ROWS(0, 0, ub)
    hq[0] = *(const u32x4*)hqp;
#pragma unroll
    for (int ti = 0; ti < 8; ++ti) {
        const int cur = ti & 1, nxt = cur ^ 1;
        if (ti + 1 < 8) { PEER_ISSUE_ROWS(nxt, ti + 1, ub) hq[nxt] = *(const u32x4*)(hqp + (size_t)(ti + 1) * 1024); }
        if (ti + 2 < 8) { idv[cur][0] = *(const u32x4*)(idp + (ti + 2) * 128); idv[cur][1] = *(const u32x4*)(idp + (ti + 2) * 128 + 8); }
        int pd[16];
#pragma unroll
        for (int i = 0; i < 16; ++i) {
            const u32x4 uq = rows[cur][i];
            int sm = __builtin_amdgcn_sdot4((int)uq.x, (int)hq[cur].x, 0, false);
            sm = __builtin_amdgcn_sdot4((int)uq.y, (int)hq[cur].y, sm, false); sm = __builtin_amdgcn_sdot4((int)uq.z, (int)hq[cur].z, sm, false); sm = __builtin_amdgcn_sdot4((int)uq.w, (int)hq[cur].w, sm, false);
            pd[i] = sm;
        }
#pragma unroll
        for (int r = 0; r < 8; ++r) { const bool up = (lane & 4) != 0; const int keep = up ? pd[r + 8] : pd[r], send = up ? pd[r] : pd[r + 8]; pd[r] = keep + __shfl_xor(send, 4); }
#pragma unroll
        for (int r = 0; r < 4; ++r) { const bool up = (lane & 2) != 0; const int keep = up ? pd[r + 4] : pd[r], send = up ? pd[r] : pd[r + 4]; pd[r] = keep + __shfl_xor(send, 2); }
#pragma unroll
        for (int r = 0; r < 2; ++r) { const bool up = (lane & 1) != 0; const int keep = up ? pd[r + 2] : pd[r], send = up ? pd[r] : pd[r + 2]; pd[r] = keep + __shfl_xor(send, 1); }
        const unsigned o = ((unsigned)((pd[0] + 32) >> 6) & 0xFFFFu) | ((unsigned)((pd[1] + 32) >> 6) << 16);
        *(unsigned*)(p.ws + OFF_PD + (((size_t)s * NT + tokw + ti) * 128 + 2 * lane) * 2) = o;
    }
    (void)lds;
}
__device__ __forceinline__ void ph_peer_coef(const P& p) {
    const int tid = tidx(), wid = tid >> 6, lane = tid & 63;
    for (unsigned tb = (VBID * 4 + wid) * 4; tb < (unsigned)NT; tb += VGRID * 16) {
        int s0[4], s1[4]; unsigned idw[4]; f32x2 gt[4]; float hs[4];
#pragma unroll
        for (int q = 0; q < 4; ++q) {
            const unsigned tok = tb + q;
            s0[q] = 0; s1[q] = 0;
#pragma unroll
            for (int s = 0; s < 8; ++s) { const unsigned v = *(const unsigned*)(p.ws + OFF_PD + (((size_t)s * NT + tok) * 128 + 2 * lane) * 2); s0[q] += (int)(short)(v & 0xFFFFu); s1[q] += (int)(short)(v >> 16); }
            idw[q] = *(const unsigned*)(WS(unsigned short, OFF_IDSP) + (size_t)tok * 128 + 2 * lane);
            gt[q] = *(const f32x2*)(WS(float, OFF_GATEP) + (size_t)tok * 128 + 2 * lane);
            hs[q] = WS(float, OFF_HSC)[tok];
        }
        float su0[4], su1[4], sv0[4], sv1[4];
#pragma unroll
        for (int q = 0; q < 4; ++q) { const unsigned id0 = idw[q] & 0xFFFFu, id1 = idw[q] >> 16; su0[q] = WS(float, OFF_SU)[id0]; su1[q] = WS(float, OFF_SU)[id1]; sv0[q] = WS(float, OFF_SV)[id0]; sv1[q] = WS(float, OFF_SV)[id1]; }
#pragma unroll
        for (int q = 0; q < 4; ++q) {
            const unsigned tok = tb + q;
            const float c0 = gelu_erf((float)(s0[q] << 6) * hs[q] * su0[q]) * gt[q].x * sv0[q];
            const float c1 = gelu_erf((float)(s1[q] << 6) * hs[q] * su1[q]) * gt[q].y * sv1[q];
            const float am = wave_max(fmaxf(fabsf(c0), fabsf(c1)));
            const float inv = am > 0.f ? 127.0f / am : 0.f;
            const unsigned q0 = (unsigned)(int)rintf(c0 * inv) & 0xFFu, q1 = (unsigned)(int)rintf(c1 * inv) & 0xFFu;
            *(unsigned short*)(p.ws + OFF_COEF + (size_t)tok * 128 + 2 * lane) = (unsigned short)(q0 | (q1 << 8));
            if (lane == 0) WS(float, OFF_CSC)[tok] = am * (1.0f / 127.0f);
        }
    }
}
__device__ __forceinline__ void peer_v_unit(const P& p, unsigned tile, unsigned s, unsigned char* lds) {
    const int tid = tidx(), wid = tid >> 6, lane = tid & 63, g = lane >> 3, cg = lane & 7;
    const unsigned char* vb = p.ws + OFF_VQ + s * 128 + cg * 16;
    const size_t tokw = (size_t)tile * 32 + wid * 8;
    const unsigned short* idp = WS(unsigned short, OFF_IDSP) + tokw * 128 + g * 16;
    const unsigned char* cqp = p.ws + OFF_COEF + tokw * 128 + g * 16;
    u32x4 idv[2][2], rows[2][16], cq[2];
    idv[0][0] = *(const u32x4*)idp; idv[0][1] = *(const u32x4*)(idp + 8);
    idv[1][0] = *(const u32x4*)(idp + 128); idv[1][1] = *(const u32x4*)(idp + 136);
    PEER_ISSUE_ROWS(0, 0, vb)
    cq[0] = *(const u32x4*)cqp;
#pragma unroll
    for (int ti = 0; ti < 8; ++ti) {
        const int cur = ti & 1, nxt = cur ^ 1;
        const size_t tok = tokw + ti;
        if (ti + 1 < 8) { PEER_ISSUE_ROWS(nxt, ti + 1, vb) cq[nxt] = *(const u32x4*)(cqp + (ti + 1) * 128); }
        if (ti + 2 < 8) { idv[cur][0] = *(const u32x4*)(idp + (ti + 2) * 128); idv[cur][1] = *(const u32x4*)(idp + (ti + 2) * 128 + 8); }
        int acc[16];
#pragma unroll
        for (int e = 0; e < 16; ++e) acc[e] = 0;
#pragma unroll
        for (int q = 0; q < 4; ++q) {
            const int cw = (int)cq[cur][q];
#pragma unroll
            for (int d = 0; d < 4; ++d) {
                const unsigned a = rows[cur][4 * q][d], bq = rows[cur][4 * q + 1][d], c = rows[cur][4 * q + 2][d], dd = rows[cur][4 * q + 3][d];
                const unsigned x0 = __builtin_amdgcn_perm(bq, a, 0x05010400u), x1 = __builtin_amdgcn_perm(bq, a, 0x07030602u);
                const unsigned y0 = __builtin_amdgcn_perm(dd, c, 0x05010400u), y1 = __builtin_amdgcn_perm(dd, c, 0x07030602u);
                const unsigned t0 = __builtin_amdgcn_perm(y0, x0, 0x05040100u), t1 = __builtin_amdgcn_perm(y0, x0, 0x07060302u);
                const unsigned t2 = __builtin_amdgcn_perm(y1, x1, 0x05040100u), t3 = __builtin_amdgcn_perm(y1, x1, 0x07060302u);
                acc[4 * d] = __builtin_amdgcn_sdot4((int)t0, cw, acc[4 * d], false); acc[4 * d + 1] = __builtin_amdgcn_sdot4((int)t1, cw, acc[4 * d + 1], false);
                acc[4 * d + 2] = __builtin_amdgcn_sdot4((int)t2, cw, acc[4 * d + 2], false); acc[4 * d + 3] = __builtin_amdgcn_sdot4((int)t3, cw, acc[4 * d + 3], false);
            }
        }
#pragma unroll
        for (int r = 0; r < 8; ++r) { const bool up = (lane & 32) != 0; const int keep = up ? acc[r + 8] : acc[r], send = up ? acc[r] : acc[r + 8]; acc[r] = keep + __shfl_xor(send, 32); }
#pragma unroll
        for (int r = 0; r < 4; ++r) { const bool up = (lane & 16) != 0; const int keep = up ? acc[r + 4] : acc[r], send = up ? acc[r] : acc[r + 4]; acc[r] = keep + __shfl_xor(send, 16); }
#pragma unroll
        for (int r = 0; r < 2; ++r) { const bool up = (lane & 8) != 0; const int keep = up ? acc[r + 2] : acc[r], send = up ? acc[r] : acc[r + 2]; acc[r] = keep + __shfl_xor(send, 8); }
        const float csc = WS(float, OFF_CSC)[tok];
        const int col = (int)s * 128 + cg * 16 + 2 * g;
        const unsigned hw = *(const unsigned*)(WS(bf16, OFF_R1) + tok * 1024 + col);
        const float y0 = ALPHA * __uint_as_float(hw << 16) + csc * (float)acc[0], y1 = ALPHA * __uint_as_float(hw & 0xFFFF0000u) + csc * (float)acc[1];
        *(unsigned*)(WS(bf16, OFF_Y2B) + tok * 1024 + col) = pack_bf2(y0, y1);
        const float s1 = wave_sum(y0 + y1), s2 = wave_sum(y0 * y0 + y1 * y1);
        if (lane == 0) { atomicAdd(WS(float, OFF_STAT) + tok * 2, s1); atomicAdd(WS(float, OFF_STAT) + tok * 2 + 1, s2); }
    }
    (void)lds;
}
__device__ __forceinline__ void ph_ln2(const P& p) {
    const int tid = tidx(), wid = tid >> 6, lane = tid & 63;
    f32x4 gg[4], bb[4];
#pragma unroll
    for (int i = 0; i < 4; ++i) { gg[i] = *(const f32x4*)(p.ln2_g + i * 256 + lane * 4); bb[i] = *(const f32x4*)(p.ln2_b + i * 256 + lane * 4); }
    for (unsigned tb = (VBID * 4 + wid) * 4; tb < (unsigned)NT; tb += VGRID * 16) {
        f32x2 st[4]; u32x2 yr[4][4];
#pragma unroll
        for (int q = 0; q < 4; ++q) { st[q] = *(const f32x2*)(WS(float, OFF_STAT) + (size_t)(tb + q) * 2);
#pragma unroll
            for (int i = 0; i < 4; ++i) yr[q][i] = *(const u32x2*)(WS(bf16, OFF_Y2B) + (size_t)(tb + q) * 1024 + i * 256 + lane * 4); }
#pragma unroll
        for (int q = 0; q < 4; ++q) {
            const float mu = st[q].x * (1.0f / 1024.0f), rs = rsqrtf(fmaxf(st[q].y * (1.0f / 1024.0f) - mu * mu, 0.f) + 1e-5f);
            float* orow = p.out + (size_t)(tb + q) * 1024;
#pragma unroll
            for (int i = 0; i < 4; ++i) {
                const f32x4 y = (f32x4){__uint_as_float(yr[q][i].x << 16), __uint_as_float(yr[q][i].x & 0xFFFF0000u), __uint_as_float(yr[q][i].y << 16), __uint_as_float(yr[q][i].y & 0xFFFF0000u)};
                *(f32x4*)(orow + i * 256 + lane * 4) = (y - mu) * rs * gg[i] + bb[i];
            }
        }
    }
}

__device__ __forceinline__ void conv_tile(const P& p, int b, int c, int ch0, unsigned char* T, bf16* nat, int nat_ld, int nat_col0) {
    const int tid = tidx(), cg = tid & 15, lb = tid >> 4, ch = ch0 + cg * 8;
    float w[4][8], bias[8];
#pragma unroll
    for (int j = 0; j < 4; ++j) { const f32x4 a = *(const f32x4*)(p.conv_w + j * 1024 + ch), bq = *(const f32x4*)(p.conv_w + j * 1024 + ch + 4);
#pragma unroll
        for (int e = 0; e < 4; ++e) { w[j][e] = a[e]; w[j][4 + e] = bq[e]; } }
    { const f32x4 a = *(const f32x4*)(p.conv_b + ch), bq = *(const f32x4*)(p.conv_b + ch + 4);
#pragma unroll
      for (int e = 0; e < 4; ++e) { bias[e] = a[e]; bias[4 + e] = bq[e]; } }
    const bf16* base = WS(bf16, OFF_XBC) + (size_t)b * SEQ * 1024 + ch;
#pragma unroll 1
    for (int hb = 0; hb < 2; ++hb) {
        const int s0 = c * 128 + lb * 8 + hb * 4;
        float R[4][8];
#pragma unroll
        for (int i = 0; i < 7; ++i) {
            const int sp = s0 - 3 + i;
            u32x4 raw = (u32x4){0u, 0u, 0u, 0u};
            if (sp >= 0) raw = *(const u32x4*)(base + (size_t)sp * 1024);
#pragma unroll
            for (int e = 0; e < 4; ++e) { R[i & 3][2 * e] = __uint_as_float(raw[e] << 16); R[i & 3][2 * e + 1] = __uint_as_float(raw[e] & 0xFFFF0000u); }
            if (i >= 3) {
                const int l = lb * 8 + hb * 4 + (i - 3);
                float v[8];
#pragma unroll
                for (int e = 0; e < 8; ++e) { v[e] = bias[e] + w[0][e] * R[(i - 3) & 3][e] + w[1][e] * R[(i - 2) & 3][e] + w[2][e] * R[(i - 1) & 3][e] + w[3][e] * R[i & 3][e]; v[e] = silu_f(v[e]); }
                u32x4 o; o.x = pack_bf2(v[0], v[1]); o.y = pack_bf2(v[2], v[3]); o.z = pack_bf2(v[4], v[5]); o.w = pack_bf2(v[6], v[7]);
                *(u32x4*)(T + l * 256 + ((cg ^ (l & 15)) * 16)) = o;
                if (nat) *(u32x4*)(nat + ((size_t)b * SEQ + c * 128 + l) * nat_ld + nat_col0 + cg * 8) = o;
            }
        }
    }
}
__device__ __forceinline__ void tile_transposed_store(const unsigned char* T, bf16* dst) {
    const int tid = tidx(), lg = tid & 15, cb = tid >> 4;
#pragma unroll
    for (int it = 0; it < 8; ++it) {
        const int ch = cb + 16 * it;
        unsigned e[8];
#pragma unroll
        for (int i = 0; i < 8; ++i) { const int l = lg * 8 + i; e[i] = *(const unsigned short*)(T + l * 256 + (((ch >> 3) ^ (l & 15)) * 16) + (ch & 7) * 2); }
        u32x4 o; o.x = e[0] | (e[1] << 16); o.y = e[2] | (e[3] << 16); o.z = e[4] | (e[5] << 16); o.w = e[6] | (e[7] << 16);
        *(u32x4*)(dst + (size_t)ch * SEQ + lg * 8) = o;
    }
}
__device__ __forceinline__ void conv_unit(const P& p, unsigned u, unsigned char* lds) {
    unsigned char* T0 = lds; unsigned char* T1 = lds + 32768;
    if (u < 1024u) {
        const int hp = (int)(u & 3u), c = (int)((u >> 2) & 15u), b = (int)(u >> 6);
        conv_tile(p, b, c, hp * 128, T0, nullptr, 0, 0);
        half_sync();
        tile_transposed_store(T0, WS(bf16, OFF_XT) + ((size_t)b * 512 + hp * 128) * SEQ + c * 128);
        half_sync();
    } else {
        const unsigned v = u - 1024u; const int g = (int)(v & 1u), c = (int)((v >> 1) & 15u), b = (int)(v >> 5);
        conv_tile(p, b, c, 512 + g * 128, T0, nullptr, 0, 0);
        conv_tile(p, b, c, 768 + g * 128, T1, WS(bf16, OFF_CN), 256, g * 128);
        half_sync();
        tile_transposed_store(T0, WS(bf16, OFF_BT) + ((size_t)(b * 2 + g) * 128) * SEQ + c * 128);
        const int wid = tidx() >> 6, lane = tidx() & 63, fr = lane & 15, fq = lane >> 4;
        f32x4 acc[8][2];
#pragma unroll
        for (int nt = 0; nt < 8; ++nt) { acc[nt][0] = (f32x4){0.f, 0.f, 0.f, 0.f}; acc[nt][1] = (f32x4){0.f, 0.f, 0.f, 0.f}; }
#pragma unroll
        for (int ks = 0; ks < 4; ++ks) {
            bf16x8 cf[2];
#pragma unroll
            for (int lt = 0; lt < 2; ++lt) cf[lt] = *(const bf16x8*)(T1 + (wid * 32 + lt * 16 + fr) * 256 + (((ks * 4 + fq) ^ fr) * 16));
#pragma unroll
            for (int nt = 0; nt < 8; ++nt) if (nt < 2 * wid + 2) {
                const bf16x8 bfg = *(const bf16x8*)(T0 + (nt * 16 + fr) * 256 + (((ks * 4 + fq) ^ fr) * 16));
                acc[nt][0] = __builtin_amdgcn_mfma_f32_16x16x32_bf16(bfg, cf[0], acc[nt][0], 0, 0, 0);
                acc[nt][1] = __builtin_amdgcn_mfma_f32_16x16x32_bf16(bfg, cf[1], acc[nt][1], 0, 0, 0);
            }
        }
        bf16* cbp = WS(bf16, OFF_CB) + ((size_t)((b * 16 + c) * 2 + g)) * 16384;
#pragma unroll
        for (int nt = 0; nt < 8; ++nt) if (nt < 2 * wid + 2)
#pragma unroll
            for (int lt = 0; lt < 2; ++lt) { u32x2 o; o.x = pack_bf2(acc[nt][lt][0], acc[nt][lt][1]); o.y = pack_bf2(acc[nt][lt][2], acc[nt][lt][3]); *(u32x2*)(cbp + (wid * 32 + lt * 16 + fr) * 128 + nt * 16 + 4 * fq) = o; }
        half_sync();
    }
}
__device__ __forceinline__ void scanw_unit(const P& p, unsigned u) {
    const int tid = tidx(), wid = tid >> 6, lane = tid & 63;
    const int c = (int)(u & 15u), b = (int)(u >> 4);
    const size_t tokb = (size_t)b * SEQ + c * 128;
#pragma unroll
    for (int hh = 0; hh < 2; ++hh) {
        const int h = wid * 2 + hh;
        const float A = -__expf(p.a_log[h]);
        const float dt0 = WS(float, OFF_DT)[(tokb + lane) * 8 + h], dt1 = WS(float, OFF_DT)[(tokb + 64 + lane) * 8 + h];
        const float s0 = wave_incl_scan(dt0 * A, lane);
        const float t0 = __shfl(s0, 63);
        const float s1 = wave_incl_scan(dt1 * A, lane) + t0;
        const float total = __shfl(s1, 63);
        float* wl = WS(float, OFF_WL) + (size_t)(b * 8 + h) * SEQ + c * 128;
        wl[lane] = dt0 * __expf(total - s0); wl[64 + lane] = dt1 * __expf(total - s1);
        if (lane == 0) WS(float, OFF_TOT)[(b * 8 + h) * 16 + c] = total;
    }
}
__device__ __forceinline__ void ph_conv(const P& p, unsigned char* lds) {
    for (unsigned u = VBID; u < 1536u + 256u; u += VGRID) { if (u < 1536u) conv_unit(p, u, lds); else scanw_unit(p, u - 1536u); }
}

template <int LD = SEQ>
__device__ __forceinline__ void ssd_stage(const bf16* xt  , int c, unsigned char* st, int wid, int lane) {
#pragma unroll
    for (int i = 0; i < 4; ++i) {
        const int piece = wid * 4 + i, row = piece * 4 + (lane >> 4), chk = (lane & 15) ^ (row & 15);
        __builtin_amdgcn_global_load_lds((const u32*)(xt + (size_t)row * LD + c * 128 + chk * 8), (u32*)(st + piece * 1024 + lane * 16), 16, 0, 0);
    }
}
__device__ __forceinline__ void ssd_state_unit(const P& p, unsigned u, unsigned char* lds) {
    const int tid = tidx();
    const int b = (int)(u >> 3), h = (int)(u & 7u), g = h >> 2;
    const bf16* xt = WS(bf16, OFF_XT) + (size_t)(b * 8 + h) * 64 * SEQ;
    unsigned char* XTB = lds;
    f32x4 st[2][4];
#pragma unroll
    for (int nt = 0; nt < 2; ++nt)
#pragma unroll
        for (int pt = 0; pt < 4; ++pt) st[nt][pt] = (f32x4){0.f, 0.f, 0.f, 0.f};
    ssd_stage(xt, 0, XTB, tid >> 6, tid & 63);
    ssd_stage(xt, 1, XTB + 16384, tid >> 6, tid & 63);
    bf16x8 bfg[4][2]; f32x4 wv[4][2]; float total;
    {
        const int wid = tid >> 6, lane = tid & 63, fr = lane & 15, fq = lane >> 4;
        const bf16* btp = WS(bf16, OFF_BT) + ((size_t)(b * 2 + g) * 128 + wid * 32 + fr) * SEQ + 8 * fq;
        const float* wlp = WS(float, OFF_WL) + (size_t)(b * 8 + h) * SEQ + 8 * fq;
#pragma unroll
        for (int ks = 0; ks < 4; ++ks) { bfg[ks][0] = *(const bf16x8*)(btp + ks * 32); bfg[ks][1] = *(const bf16x8*)(btp + (size_t)16 * SEQ + ks * 32); wv[ks][0] = *(const f32x4*)(wlp + ks * 32); wv[ks][1] = *(const f32x4*)(wlp + ks * 32 + 4); }
        total = WS(float, OFF_TOT)[(b * 8 + h) * 16];
    }
    for (int c = 0; c < 15; ++c) {
        int tid_c = tid; asm volatile("" : "+v"(tid_c));
        const int wid = tid_c >> 6, lane = tid_c & 63, fr = lane & 15, fq = lane >> 4;
        bf16x8 bw[4][2];
#pragma unroll
        for (int ks = 0; ks < 4; ++ks)
#pragma unroll
            for (int nt = 0; nt < 2; ++nt) {
                const u32x4 raw = __builtin_bit_cast(u32x4, bfg[ks][nt]);
                float m[8];
#pragma unroll
                for (int e = 0; e < 4; ++e) { m[2 * e] = __uint_as_float(raw[e] << 16); m[2 * e + 1] = __uint_as_float(raw[e] & 0xFFFF0000u); }
#pragma unroll
                for (int e = 0; e < 8; ++e) m[e] *= (e < 4 ? wv[ks][0][e & 3] : wv[ks][1][e & 3]);
                u32x4 pk; pk.x = pack_bf2(m[0], m[1]); pk.y = pack_bf2(m[2], m[3]); pk.z = pack_bf2(m[4], m[5]); pk.w = pack_bf2(m[6], m[7]);
                bw[ks][nt] = __builtin_bit_cast(bf16x8, pk);
            }
        const float cd = __expf(total);
        asm volatile("s_waitcnt vmcnt(12)" ::: "memory");
        half_sync();
        if (c + 1 < 15) {
            const bf16* btp = WS(bf16, OFF_BT) + ((size_t)(b * 2 + g) * 128 + wid * 32 + fr) * SEQ + (c + 1) * 128 + 8 * fq;
            const float* wlp = WS(float, OFF_WL) + (size_t)(b * 8 + h) * SEQ + (c + 1) * 128 + 8 * fq;
#pragma unroll
            for (int ks = 0; ks < 4; ++ks) { bfg[ks][0] = *(const bf16x8*)(btp + ks * 32); bfg[ks][1] = *(const bf16x8*)(btp + (size_t)16 * SEQ + ks * 32); wv[ks][0] = *(const f32x4*)(wlp + ks * 32); wv[ks][1] = *(const f32x4*)(wlp + ks * 32 + 4); }
            total = WS(float, OFF_TOT)[(b * 8 + h) * 16 + c + 1];
        }
        if (c + 2 < 15) ssd_stage(xt, c + 2, XTB + ((c + 2) % 3) * 16384, wid, lane);
        const unsigned char* X = XTB + (c % 3) * 16384;
#pragma unroll
        for (int nt = 0; nt < 2; ++nt)
#pragma unroll
            for (int pt = 0; pt < 4; ++pt) st[nt][pt] *= cd;
#pragma unroll
        for (int ks = 0; ks < 4; ++ks)
#pragma unroll
            for (int pt = 0; pt < 4; ++pt) {
                const bf16x8 xf = *(const bf16x8*)(X + (pt * 16 + fr) * 256 + (((ks * 4 + fq) ^ fr) * 16));
                st[0][pt] = __builtin_amdgcn_mfma_f32_16x16x32_bf16(bw[ks][0], xf, st[0][pt], 0, 0, 0);
                st[1][pt] = __builtin_amdgcn_mfma_f32_16x16x32_bf16(bw[ks][1], xf, st[1][pt], 0, 0, 0);
            }
        bf16* pvo = WS(bf16, OFF_PREV) + ((size_t)((b * 8 + h) * 16 + c + 1)) * 8192;
#pragma unroll
        for (int nt = 0; nt < 2; ++nt)
#pragma unroll
            for (int pt = 0; pt < 4; ++pt) {
                u32x2 o; o.x = pack_bf2(st[nt][pt][0], st[nt][pt][1]); o.y = pack_bf2(st[nt][pt][2], st[nt][pt][3]);
                *(u32x2*)(pvo + (pt * 16 + fr) * 128 + wid * 32 + nt * 16 + 4 * fq) = o;
            }
    }
    asm volatile("s_waitcnt vmcnt(0)" ::: "memory");
    half_sync();
    if (tid == 0) {
        __builtin_amdgcn_fence(__ATOMIC_RELEASE, "agent");
        asm volatile("s_waitcnt vmcnt(0)" ::: "memory");
        __hip_atomic_fetch_add((unsigned*)(p.ws + OFF_CTRL + 14336 + 1024), 1u, __ATOMIC_RELAXED, __HIP_MEMORY_SCOPE_AGENT);
    }
    half_sync();
}
__device__ __forceinline__ void ssd_out_unit(const P& p, unsigned u, unsigned char* lds) {
    const int tid = tidx(), wid = tid >> 6, lane = tid & 63, fr = lane & 15, fq = lane >> 4;
    const int h = (int)(u & 7u), c = (int)((u >> 3) & 15u), b = (int)(u >> 7), g = h >> 2;
    const float A = -__expf(p.a_log[h]), Dh = p.d_skip[h];
    unsigned char* X = lds; unsigned char* PV = lds + 16384; float* par_acs = (float*)(lds + 32768); float* par_dt = par_acs + 128;
    const size_t tokb = (size_t)b * SEQ + c * 128;
    const int lrow0 = wid * 32 + fr;
    ssd_stage(WS(bf16, OFF_XT) + (size_t)(b * 8 + h) * 64 * SEQ, c, X, wid, lane);
    if (c > 0) ssd_stage<128>(WS(bf16, OFF_PREV) + ((size_t)((b * 8 + h) * 16 + c)) * 8192, 0, PV, wid, lane);
    bf16x8 cf[4][2];
    if (c > 0) {
#pragma unroll
        for (int ks = 0; ks < 4; ++ks)
#pragma unroll
            for (int lt = 0; lt < 2; ++lt) cf[ks][lt] = *(const bf16x8*)(WS(bf16, OFF_CN) + (tokb + lrow0 + 16 * lt) * 256 + g * 128 + ks * 32 + 8 * fq);
    }
    const bf16* cbp = WS(bf16, OFF_CB) + ((size_t)((b * 16 + c) * 2 + g)) * 16384;
    u32x4 cbr[4][2];
#pragma unroll
    for (int ks = 0; ks < 4; ++ks) if (ks <= wid)
#pragma unroll
        for (int lt = 0; lt < 2; ++lt) cbr[ks][lt] = *(const u32x4*)(cbp + (lrow0 + 16 * lt) * 128 + ks * 32 + 8 * fq);
    u32x2 zr[2][4];
#pragma unroll
    for (int lt = 0; lt < 2; ++lt)
#pragma unroll
        for (int pt = 0; pt < 4; ++pt) zr[lt][pt] = *(const u32x2*)(WS(bf16, OFF_Z) + (tokb + lrow0 + 16 * lt) * 512 + h * 64 + pt * 16 + 4 * fq);
    {
        const float dt0 = WS(float, OFF_DT)[(tokb + lane) * 8 + h], dt1 = WS(float, OFF_DT)[(tokb + 64 + lane) * 8 + h];
        const float s0 = wave_incl_scan(dt0 * A, lane);
        const float t0 = __shfl(s0, 63);
        const float s1 = wave_incl_scan(dt1 * A, lane) + t0;
        if (wid == 0) { par_acs[lane] = s0; par_acs[64 + lane] = s1; par_dt[lane] = dt0; par_dt[64 + lane] = dt1; }
    }
    asm volatile("s_waitcnt vmcnt(0)" ::: "memory");
    half_sync();
    f32x4 y[4][2];
#pragma unroll
    for (int pt = 0; pt < 4; ++pt) { y[pt][0] = (f32x4){0.f, 0.f, 0.f, 0.f}; y[pt][1] = (f32x4){0.f, 0.f, 0.f, 0.f}; }
    float acsl[2];
#pragma unroll
    for (int lt = 0; lt < 2; ++lt) acsl[lt] = par_acs[lrow0 + 16 * lt];
    if (c > 0) {
#pragma unroll
        for (int ks = 0; ks < 4; ++ks)
#pragma unroll
            for (int pt = 0; pt < 4; ++pt) {
                const bf16x8 pf = *(const bf16x8*)(PV + (pt * 16 + fr) * 256 + (((ks * 4 + fq) ^ fr) * 16));
                y[pt][0] = __builtin_amdgcn_mfma_f32_16x16x32_bf16(pf, cf[ks][0], y[pt][0], 0, 0, 0);
                y[pt][1] = __builtin_amdgcn_mfma_f32_16x16x32_bf16(pf, cf[ks][1], y[pt][1], 0, 0, 0);
            }
#pragma unroll
        for (int lt = 0; lt < 2; ++lt) { const float el = __expf(acsl[lt]);
#pragma unroll
            for (int pt = 0; pt < 4; ++pt) y[pt][lt] *= el; }
    }
#pragma unroll
    for (int ks = 0; ks < 4; ++ks) if (ks <= wid) {
        const int j0 = ks * 32 + 8 * fq;
        const f32x4 aj0 = *(const f32x4*)(par_acs + j0), aj1 = *(const f32x4*)(par_acs + j0 + 4), dj0 = *(const f32x4*)(par_dt + j0), dj1 = *(const f32x4*)(par_dt + j0 + 4);
        bf16x8 mf[2];
#pragma unroll
        for (int lt = 0; lt < 2; ++lt) {
            const int l = lrow0 + 16 * lt;
            const u32x4 raw = cbr[ks][lt];
            float m[8];
#pragma unroll
            for (int e = 0; e < 4; ++e) { m[2 * e] = __uint_as_float(raw[e] << 16); m[2 * e + 1] = __uint_as_float(raw[e] & 0xFFFF0000u); }
#pragma unroll
            for (int e = 0; e < 8; ++e) { const float aj = e < 4 ? aj0[e & 3] : aj1[e & 3], dj = e < 4 ? dj0[e & 3] : dj1[e & 3];
                m[e] = (j0 + e <= l) ? m[e] * __expf(acsl[lt] - aj) * dj : 0.f; }
            u32x4 pk; pk.x = pack_bf2(m[0], m[1]); pk.y = pack_bf2(m[2], m[3]); pk.z = pack_bf2(m[4], m[5]); pk.w = pack_bf2(m[6], m[7]);
            mf[lt] = __builtin_bit_cast(bf16x8, pk);
        }
#pragma unroll
        for (int pt = 0; pt < 4; ++pt) {
            const bf16x8 xf = *(const bf16x8*)(X + (pt * 16 + fr) * 256 + (((ks * 4 + fq) ^ fr) * 16));
            y[pt][0] = __builtin_amdgcn_mfma_f32_16x16x32_bf16(xf, mf[0], y[pt][0], 0, 0, 0);
            y[pt][1] = __builtin_amdgcn_mfma_f32_16x16x32_bf16(xf, mf[1], y[pt][1], 0, 0, 0);
        }
    }
#pragma unroll
    for (int lt = 0; lt < 2; ++lt) {
        const size_t tok = tokb + lrow0 + 16 * lt;
        const int lq = lrow0 + 16 * lt;
        float ss = 0.f;
#pragma unroll
        for (int pt = 0; pt < 4; ++pt) {
            const int col = h * 64 + pt * 16 + 4 * fq;
            const u32x2 zq = zr[lt][pt];
            float xv[4];
#pragma unroll
            for (int e = 0; e < 4; ++e) { const int pr = pt * 16 + 4 * fq + e; xv[e] = bf2f(*(const bf16*)(X + pr * 256 + (((lq >> 3) ^ (pr & 15)) * 16) + (lq & 7) * 2)); }
            const float zv[4] = {__uint_as_float(zq.x << 16), __uint_as_float(zq.x & 0xFFFF0000u), __uint_as_float(zq.y << 16), __uint_as_float(zq.y & 0xFFFF0000u)};
            float gv[4];
#pragma unroll
            for (int e = 0; e < 4; ++e) { gv[e] = (y[pt][lt][e] + Dh * xv[e]) * silu_f(zv[e]); ss += gv[e] * gv[e]; }
            u32x2 o; o.x = pack_bf2(gv[0], gv[1]); o.y = pack_bf2(gv[2], gv[3]);
            *(u32x2*)(WS(bf16, OFF_R1) + tok * 1024 + 512 + col) = o;
        }
        ss += __shfl_xor(ss, 16); ss += __shfl_xor(ss, 32);
        if (fq == 0) atomicAdd(WS(float, OFF_SSQ) + tok * 2 + g, ss);
    }
    half_sync();
}

__device__ __forceinline__ u32 cvt_pk_bf16(float lo, float hi) { return pack_bf2(lo, hi); }
__device__ __forceinline__ void attn_stage(const bf16* Kb, const bf16* Vb, int kt, unsigned char* st, int wid, int lane) {
#pragma unroll
    for (int i = 0; i < 4; ++i) {
        const int piece = wid * 4 + i, c = piece >> 3, r = (piece & 7) * 8 + (lane >> 3), ch = (lane & 7) ^ (r & 7);
        __builtin_amdgcn_global_load_lds((const u32*)(Kb + (size_t)(kt * 64 + r) * 512 + c * 64 + ch * 8), (u32*)(st + piece * 1024 + lane * 16), 16, 0, 0);
        const int rv = piece * 8 + (lane >> 3), chv = (lane & 7) ^ ((rv >> 1) & 7);
        __builtin_amdgcn_global_load_lds((const u32*)(Vb + (size_t)rv * SEQ + kt * 64 + chv * 8), (u32*)(st + 16384 + piece * 1024 + lane * 16), 16, 0, 0);
    }
}
__device__ __forceinline__ void attn_unit(const P& p, int qb, int bh, unsigned char* lds) {
    const int tid = tidx(), wid = tid >> 6, lane = tid & 63, fr = lane & 15, fq = lane >> 4;
    const int b = bh >> 2, h = bh & 3;
    const bf16* Kb = WS(bf16, OFF_KR) + (size_t)b * SEQ * 512 + h * 128;
    const bf16* Vb = WS(bf16, OFF_VTT) + (size_t)bh * 128 * SEQ;
    const int qrow = qb * 64 + wid * 16 + fr;
    const bf16* qp = WS(bf16, OFF_QR) + ((size_t)b * SEQ + qrow) * 512 + h * 128 + 8 * fq;
    bf16x8 qf[2][2];
#pragma unroll
    for (int c = 0; c < 2; ++c)
#pragma unroll
        for (int ks = 0; ks < 2; ++ks) qf[c][ks] = *(const bf16x8*)(qp + c * 64 + ks * 32);
    f32x4 O[2][8];
#pragma unroll
    for (int c = 0; c < 2; ++c)
#pragma unroll
        for (int d = 0; d < 8; ++d) O[c][d] = (f32x4){0.f, 0.f, 0.f, 0.f};
    float mrun[2] = {-1e30f, -1e30f}, lrun[2] = {0.f, 0.f};
    const int ntile = qb + 1;
    attn_stage(Kb, Vb, 0, lds, wid, lane);
    auto tile = [&](const int kt, auto diag) {
        const unsigned char* cur = lds + (kt & 1) * 32768;
        asm volatile("s_waitcnt vmcnt(0)" ::: "memory");
        half_sync();
        if (kt + 1 < ntile) attn_stage(Kb, Vb, kt + 1, lds + ((kt + 1) & 1) * 32768, wid, lane);
        f32x4 s[2][4];
#pragma unroll
        for (int c = 0; c < 2; ++c)
#pragma unroll
            for (int nt = 0; nt < 4; ++nt) {
                s[c][nt] = (f32x4){0.f, 0.f, 0.f, 0.f};
#pragma unroll
                for (int ks = 0; ks < 2; ++ks) {
                    const int r = nt * 16 + fr;
                    const bf16x8 kf = *(const bf16x8*)(cur + c * 8192 + r * 128 + (((ks * 4 + fq) ^ (r & 7)) * 16));
                    s[c][nt] = __builtin_amdgcn_mfma_f32_16x16x32_bf16(kf, qf[c][ks], s[c][nt], 0, 0, 0);
                }
            }
        if constexpr (decltype(diag)::value) {
            const int ql = wid * 16 + fr;
#pragma unroll
            for (int c = 0; c < 2; ++c)
#pragma unroll
                for (int nt = 0; nt < 4; ++nt)
#pragma unroll
                    for (int j = 0; j < 4; ++j) if (nt * 16 + 4 * fq + j > ql) s[c][nt][j] = -1e30f;
        }
        bf16x8 pf[2][2];
        float mxa[2], alpha[2];
#pragma unroll
        for (int c = 0; c < 2; ++c) {
            float mch = fmaxf(fmaxf(s[c][0][0], s[c][0][1]), s[c][0][2]);
            mch = fmaxf(fmaxf(mch, s[c][0][3]), s[c][1][0]); mch = fmaxf(fmaxf(mch, s[c][1][1]), s[c][1][2]); mch = fmaxf(fmaxf(mch, s[c][1][3]), s[c][2][0]);
            mch = fmaxf(fmaxf(mch, s[c][2][1]), s[c][2][2]); mch = fmaxf(fmaxf(mch, s[c][2][3]), s[c][3][0]); mch = fmaxf(fmaxf(mch, s[c][3][1]), s[c][3][2]);
            mxa[c] = fmaxf(mch, s[c][3][3]);
        }
        mxa[0] = quad_max(mxa[0]); mxa[1] = quad_max(mxa[1]);
#pragma unroll
        for (int c = 0; c < 2; ++c) {
            const bool mv = mxa[c] > mrun[c] + 8.0f; const float mn = mv ? mxa[c] : mrun[c];
            alpha[c] = mv ? __builtin_amdgcn_exp2f(mrun[c] - mn) : 1.0f; mrun[c] = mn; }
#pragma unroll
        for (int c = 0; c < 2; ++c)
#pragma unroll
            for (int nt = 0; nt < 4; ++nt)
#pragma unroll
                for (int j = 0; j < 4; ++j) s[c][nt][j] = __builtin_amdgcn_exp2f(s[c][nt][j] - mrun[c]);
#pragma unroll
        for (int c = 0; c < 2; ++c) {
            float t4[4];
#pragma unroll
            for (int nt = 0; nt < 4; ++nt) t4[nt] = (s[c][nt][0] + s[c][nt][1]) + (s[c][nt][2] + s[c][nt][3]);
            lrun[c] = lrun[c] * alpha[c] + ((t4[0] + t4[1]) + (t4[2] + t4[3]));
#pragma unroll
            for (int ks = 0; ks < 2; ++ks) {
                u32x4 w; w.x = cvt_pk_bf16(s[c][2 * ks][0], s[c][2 * ks][1]); w.y = cvt_pk_bf16(s[c][2 * ks][2], s[c][2 * ks][3]);
                w.z = cvt_pk_bf16(s[c][2 * ks + 1][0], s[c][2 * ks + 1][1]); w.w = cvt_pk_bf16(s[c][2 * ks + 1][2], s[c][2 * ks + 1][3]);
                pf[c][ks] = __builtin_bit_cast(bf16x8, w);
            }
        }
#pragma unroll
        for (int d = 0; d < 8; ++d) { O[0][d] *= alpha[0]; O[1][d] *= alpha[1]; }
#pragma unroll
        for (int d = 0; d < 8; ++d)
#pragma unroll
            for (int ks = 0; ks < 2; ++ks) {
                const int r = d * 16 + fr, sw = (r >> 1) & 7, ch = 4 * ks + (fq >> 1);
                const unsigned char* rowp = cur + 16384 + r * 128 + (fq & 1) * 8;
                const LAS3 unsigned char* rl = (const LAS3 unsigned char*)rowp; const u32x2 v0 = *(const volatile LAS3 u32x2*)(rl + ((ch ^ sw) * 16)), v1 = *(const volatile LAS3 u32x2*)(rl + (((ch + 2) ^ sw) * 16));
                const bf16x8 vf = __builtin_bit_cast(bf16x8, (u32x4){v0.x, v0.y, v1.x, v1.y});
                O[0][d] = __builtin_amdgcn_mfma_f32_16x16x32_bf16(vf, pf[0][ks], O[0][d], 0, 0, 0);
                O[1][d] = __builtin_amdgcn_mfma_f32_16x16x32_bf16(vf, pf[1][ks], O[1][d], 0, 0, 0);
            }
    };
    for (int kt = 0; kt + 1 < ntile; ++kt) tile(kt, std::false_type{});
    tile(ntile - 1, std::true_type{});
    float l0 = lrun[0], l1 = lrun[1];
    l0 = quad_sum(l0); l1 = quad_sum(l1);
    const float i0 = 1.0f / l0, i1 = WS(float, OFF_LAM)[0] / l1;
    float ss = 0.f;
#pragma unroll
    for (int d = 0; d < 8; ++d) { O[0][d] = O[0][d] * i0 - O[1][d] * i1; ss += O[0][d][0] * O[0][d][0] + O[0][d][1] * O[0][d][1] + O[0][d][2] * O[0][d][2] + O[0][d][3] * O[0][d][3]; }
    ss = quad_sum(ss);
    const float rn = rsqrtf(ss * (1.0f / 128.0f) + 1e-5f) * (1.0f - LAMBDA_INIT);
    bf16* orow = WS(bf16, OFF_R1) + ((size_t)b * SEQ + qrow) * 1024 + h * 128 + 4 * fq;
#pragma unroll
    for (int d = 0; d < 8; ++d) {
        const f32x4 g = *(const f32x4*)(p.subln_g + d * 16 + 4 * fq);
        const f32x4 o = O[0][d] * g * rn;
        u32x2 w; w.x = cvt_pk_bf16(o[0], o[1]); w.y = cvt_pk_bf16(o[2], o[3]);
        *(u32x2*)(orow + d * 16) = w;
    }
    half_sync();
}
__device__ __forceinline__ void ph_mix(const P& p, unsigned char* lds, unsigned xcc) {
    unsigned* qc = (unsigned*)(p.ws + OFF_CTRL + 14336);
    unsigned* done = (unsigned*)(p.ws + OFF_CTRL + 14336 + 1024);
    unsigned* qo = (unsigned*)(p.ws + OFF_CTRL + 14336 + 1280);
    unsigned* qq = (unsigned*)(p.ws + OFF_CTRL + 14336 + 1536);
    unsigned* qa = (unsigned*)(p.ws + OFF_CTRL + 20480);
    volatile unsigned* slot = wg_slot();
    for (;;) { const unsigned it = queue_next(qc, slot); if (it >= 128u) break; ssd_state_unit(p, it, lds); }
    for (unsigned off = 0; off < 8u; ++off) {
        const unsigned x = (xcc + off) & 7u;
        for (;;) {
            const unsigned it = queue_next(qa + 64 * x, slot);
            if (it >= 256u) break;
            attn_unit(p, 31 - (int)(it & 31u), (int)(x + 8u * (it >> 5)), lds);
        }
    }
    for (;;) { const unsigned it = queue_next(qq, slot); if (it >= 2048u) break; k_quant_tables(p, it); }
    {
        if (tidx() == 0) {
            unsigned spins = 0;
            while (__hip_atomic_load(done, __ATOMIC_RELAXED, __HIP_MEMORY_SCOPE_AGENT) < 128u) { __builtin_amdgcn_s_sleep(2); if (++spins > (1u << 22)) break; }
            __builtin_amdgcn_fence(__ATOMIC_ACQUIRE, "agent");
            asm volatile("s_waitcnt vmcnt(0)" ::: "memory");
        }
        half_sync();
    }
    for (;;) { const unsigned it = queue_next(qo, slot); if (it >= 2048u) break; ssd_out_unit(p, it, lds); }
}
#define XB_TMO      128
#define XB_XCNT(j)  (256  + 64 * (j))
#define XB_XSUB(j)  (1280 + 64 * (j))
#define XB_XGEN(j)  (2304 + 64 * (j))
#define XB_TOP      3328
#define XB_TOPGEN   3392
#define XCD_BAR_WORDS 3456
#define XB_SPIN_CAP (1u << 18)
#define LAS __attribute__((address_space(3)))
__device__ __forceinline__ unsigned xb_ld(unsigned* p)              { return __hip_atomic_load(p, __ATOMIC_RELAXED, __HIP_MEMORY_SCOPE_AGENT); }
__device__ __forceinline__ unsigned xb_add(unsigned* p, unsigned v) { return __hip_atomic_fetch_add(p, v, __ATOMIC_RELAXED, __HIP_MEMORY_SCOPE_AGENT); }
__device__ __forceinline__ unsigned xb_xcc_id() { return (unsigned)__builtin_amdgcn_s_getreg((3 << 11) | 20) & 0xFu; }
#define XB_SPIN(cond, bar) do { unsigned _sp = 0; while (cond) { __builtin_amdgcn_s_sleep(1); \
    if ((++_sp & 255u) == 0u) { if (xb_ld(&(bar)[XB_TMO])) break; if (_sp > XB_SPIN_CAP) { atomicAdd(&(bar)[XB_TMO], 1u); break; } } } } while (0)
struct XcdBarrier { unsigned* bar; unsigned x; volatile LAS unsigned* st; };
__device__ __forceinline__ XcdBarrier xcd_barrier_post(unsigned* bar, volatile LAS unsigned* st) {
    XcdBarrier b; b.bar = bar; b.x = xb_xcc_id(); b.st = st;
    if (rtid() == 0) (void)xb_add(&bar[XB_XCNT(b.x)], 1u);
    return b;
}
__device__ __forceinline__ void xcd_barrier_complete(unsigned* bar, unsigned x, unsigned& nloc, unsigned& nx) {
    const unsigned G = gridDim.x * gridDim.y * gridDim.z;
    unsigned sum, cnt, mine, sp = 0u;
    for (;;) {
        sum = 0u; cnt = 0u; mine = 0u;
#pragma unroll
        for (unsigned j = 0; j < 16; ++j) { const unsigned c = xb_ld(&bar[XB_XCNT(j)]); sum += c; cnt += (c > 0u) ? 1u : 0u; mine = (j == x) ? c : mine; }
        if (sum == G) break;
        __builtin_amdgcn_s_sleep(1);
        if ((++sp & 255u) == 0u) { if (xb_ld(&bar[XB_TMO])) break; if (sp > XB_SPIN_CAP) { atomicAdd(&bar[XB_TMO], 1u); break; } }
    }
    nloc = mine > 0u ? mine : 1u; nx = cnt > 0u ? cnt : 1u;
}
__device__ __forceinline__ void xcd_barrier(const XcdBarrier& b) {
    asm volatile("s_waitcnt vmcnt(0)" ::: "memory");
    __syncthreads();
    if (rtid() == 0) {
        unsigned* bar = b.bar;
        __builtin_amdgcn_s_waitcnt(0);
        unsigned nloc = b.st[0], nx = b.st[1];
        if (nloc == 0u) { xcd_barrier_complete(bar, b.x, nloc, nx); b.st[0] = nloc; b.st[1] = nx; }
        const unsigned old = xb_add(&bar[XB_XSUB(b.x)], 1u);
        const unsigned gen = old / nloc;
        if (old + 1u == (gen + 1u) * nloc) {
            __builtin_amdgcn_fence(__ATOMIC_RELEASE, "agent");
            asm volatile("s_waitcnt vmcnt(0)" ::: "memory");
            const unsigned og = xb_add(&bar[XB_TOP], 1u);
            const unsigned tg = og / nx;
            if (og + 1u == (tg + 1u) * nx) xb_add(&bar[XB_TOPGEN], 1u);
            else XB_SPIN(xb_ld(&bar[XB_TOPGEN]) == tg, bar);
            __builtin_amdgcn_fence(__ATOMIC_ACQUIRE, "agent");
            xb_add(&bar[XB_XGEN(b.x)], 1u);
            asm volatile("s_waitcnt vmcnt(0)" ::: "memory");
        } else {
            XB_SPIN(xb_ld(&bar[XB_XGEN(b.x)]) == gen, bar);
            __builtin_amdgcn_fence(__ATOMIC_ACQUIRE, "agent");
            asm volatile("s_waitcnt vmcnt(0)" ::: "memory");
        }
    }
    __syncthreads();
}

#define RUN(fn, n) do { for (unsigned vb_ = VBID; vb_ < (unsigned)(n); vb_ += VGRID) { fn(p, vb_, (unsigned)(n)); __syncthreads(); } } while (0)
__global__ void __launch_bounds__(512, 2) k_mega(P p) {
    unsigned char* smem = g_smem;
    unsigned char* lds = smem + vhalf() * LDS_MAIN;
    if (rtid() < 80u) *(unsigned*)(smem + 2 * LDS_MAIN + 4 * rtid()) = 0u;
    __syncthreads();
    XcdBarrier bar = xcd_barrier_post((unsigned*)(p.ws + OFF_CTRL), (volatile LAS unsigned*)(smem + 2 * LDS_MAIN));
    ph_prep(p, lds);
    xcd_barrier(bar);
    ph_inproj8(p);
    xcd_barrier(bar);
    ph_conv(p, lds);
    xcd_barrier(bar);
    ph_mix(p, lds, bar.x);
    xcd_barrier(bar);
    ph_ssd_finalize(p);
    xcd_barrier(bar);
    ph_outproj8(p);
    xcd_barrier(bar);
    ph_peerq8(p);
    xcd_barrier(bar);
    for (unsigned u = VBID; u < (unsigned)(NT / 32); u += VGRID) peer_route_unit(p, u, lds);
    xcd_barrier(bar);
    { unsigned* q = (unsigned*)(p.ws + OFF_CTRL + 16384); volatile unsigned* slot = wg_slot();
      sliced_units(q, bar.x, slot, [&](unsigned t, unsigned s) { peer_u_unit(p, t, s, lds); }); }
    xcd_barrier(bar);
    ph_peer_coef(p);
    xcd_barrier(bar);
    { unsigned* q = (unsigned*)(p.ws + OFF_CTRL + 16384 + 2048); volatile unsigned* slot = wg_slot();
      sliced_units(q, bar.x, slot, [&](unsigned t, unsigned s) { peer_v_unit(p, t, s, lds); }); }
    xcd_barrier(bar);
    ph_ln2(p);
}

extern "C" void kernel_launch(void* const* d_in, const int* in_sizes, int n_in, void* d_out, int out_size, void* d_ws, size_t ws_size, hipStream_t stream) {
    P p{};
    p.x = (const float*)d_in[0]; p.pos = (const int*)d_in[1]; p.w_in = (const float*)d_in[2]; p.w_out = (const float*)d_in[3];
    p.lq1 = (const float*)d_in[4]; p.lk1 = (const float*)d_in[5]; p.lq2 = (const float*)d_in[6]; p.lk2 = (const float*)d_in[7]; p.subln_g = (const float*)d_in[8];
    p.conv_w = (const float*)d_in[9]; p.conv_b = (const float*)d_in[10]; p.dt_bias = (const float*)d_in[11]; p.a_log = (const float*)d_in[12]; p.d_skip = (const float*)d_in[13];
    p.ssd_norm_g = (const float*)d_in[14]; p.ln1_g = (const float*)d_in[15]; p.ln1_b = (const float*)d_in[16]; p.peer_wq = (const float*)d_in[17]; p.peer_keys = (const float*)d_in[18];
    p.peer_u = (const float*)d_in[19]; p.peer_v = (const float*)d_in[20]; p.ln2_g = (const float*)d_in[21]; p.ln2_b = (const float*)d_in[22];
    p.out = (float*)d_out; p.ws = (unsigned char*)d_ws;
    static int grid = 0;
    if (!grid) {
        int dev = 0, cus = 0, per_cu = 0;
        (void)hipGetDevice(&dev);
        (void)hipDeviceGetAttribute(&cus, hipDeviceAttributeMultiprocessorCount, dev);
        (void)hipFuncSetAttribute((const void*)k_mega, hipFuncAttributeMaxDynamicSharedMemorySize, (int)LDS_BYTES);
        (void)hipOccupancyMaxActiveBlocksPerMultiprocessor(&per_cu, k_mega, 512, LDS_BYTES);
        grid = cus * (per_cu < 1 ? per_cu : 1);
    }
    (void)hipMemsetAsync(d_ws, 0, 24576, stream);
    k_mega<<<grid, 512, LDS_BYTES, stream>>>(p);
}
```
